# Optimizing an MI355X kernel written in HIP

```python
import jax, jax.numpy as jnp
from jax import lax
import numpy as np

D_MODEL = 1024
BATCH = 4
SEQ = 8192
DEPTH = 2

CHUNK = 64
N_MEM = 256
EPS = 1e-6

MEM_HEADS = 4
MEM_HEAD_DIM = 64
MEM_WIDTH = MEM_HEADS * MEM_HEAD_DIM
MAIN_WIDTH = D_MODEL - MEM_WIDTH

GLA_HEADS = 4
GLA_KEY_WIDTH = MAIN_WIDTH // 2
GLA_DK = GLA_KEY_WIDTH // GLA_HEADS
GLA_DV = MAIN_WIDTH // GLA_HEADS
GLA_GATE_RANK = 16
GLA_GATE_TAU = 16.0

FOX_HEADS = 12
FOX_HEAD_DIM = MAIN_WIDTH // FOX_HEADS
FOX_QBLOCK = 128

D_FF = 2816
N_EXPERTS = 8
TOP_K = 2

N_A_LAYERS = DEPTH // 2
N_B_LAYERS = DEPTH - N_A_LAYERS
N_DENSE = (DEPTH + 1) // 2
N_MOE = DEPTH // 2

A_IN_WIDTH = 2 * GLA_KEY_WIDTH + 2 * MAIN_WIDTH + GLA_GATE_RANK + MEM_WIDTH
B_IN_WIDTH = MAIN_WIDTH + MEM_WIDTH
KV_WIDTH = 2 * MAIN_WIDTH + FOX_HEADS

kernel_name = 'hybrid_gla_fox_yoco_moe_encoder'


def rmsnorm(x, g):
    xf = x.astype(jnp.float32)
    y = xf * lax.rsqrt(jnp.mean(xf * xf, axis=-1, keepdims=True) + EPS)
    return (y * g.astype(jnp.float32)).astype(x.dtype)


def split_cols(t, widths):
    out, start = [], 0
    for w in widths:
        out.append(t[..., start:start + w])
        start += w
    return out


def swiglu(h, w_gate, w_up, w_down):
    return (jax.nn.silu(h @ w_gate) * (h @ w_up)) @ w_down


def gla_scan(q, k, v, log_a):
    bsz, seq, heads, dk = q.shape
    dv = v.shape[-1]
    nc = seq // CHUNK

    def to_chunks(t):
        return t.astype(jnp.float32).reshape(bsz, nc, CHUNK, heads, t.shape[-1]).transpose(1, 0, 3, 2, 4)

    qc, kc, vc = to_chunks(q), to_chunks(k), to_chunks(v)
    bc = jnp.cumsum(to_chunks(log_a), axis=-2)
    causal = jnp.tril(jnp.ones((CHUNK, CHUNK), dtype=bool))

    def step(state, inp):
        q_, k_, v_, b_ = inp
        o_inter = jnp.einsum('bhtk,bhkv->bhtv', q_ * jnp.exp(b_), state)
        diff = b_[:, :, :, None, :] - b_[:, :, None, :, :]
        decay = jnp.exp(jnp.where(causal[:, :, None], diff, -jnp.inf))
        scores = jnp.sum(q_[:, :, :, None, :] * k_[:, :, None, :, :] * decay, axis=-1)
        o_intra = jnp.einsum('bhts,bhsv->bhtv', scores, v_)
        b_last = b_[:, :, -1:, :]
        state = state * jnp.exp(b_last[:, :, 0, :, None]) + jnp.einsum(
            'bhsk,bhsv->bhkv', k_ * jnp.exp(b_last - b_), v_)
        return state, o_inter + o_intra

    state0 = jnp.zeros((bsz, heads, dk, dv), jnp.float32)
    _, o = lax.scan(step, state0, (qc, kc, vc, bc))
    return o.transpose(1, 0, 3, 2, 4).reshape(bsz, seq, heads, dv).astype(v.dtype)


def fox_attention(q, k, v, c):
    bsz, seq, heads, dh = q.shape
    nb = seq // FOX_QBLOCK
    qb = q.reshape(bsz, nb, FOX_QBLOCK, heads, dh).transpose(1, 0, 3, 2, 4)
    cb = c.reshape(bsz, heads, nb, FOX_QBLOCK).transpose(2, 0, 1, 3)
    kpos = jnp.arange(seq)
    scale = dh ** -0.5

    def block(args):
        i, q_, c_ = args
        s = jnp.einsum('bhqd,bshd->bhqs', q_, k).astype(jnp.float32) * scale
        s = s + c_[..., None] - c[:, :, None, :]
        qpos = i * FOX_QBLOCK + jnp.arange(FOX_QBLOCK)
        s = jnp.where(kpos[None, :] <= qpos[:, None], s, -jnp.inf)
        p = jax.nn.softmax(s, axis=-1).astype(v.dtype)
        return jnp.einsum('bhqs,bshd->bhqd', p, v)

    o = lax.map(block, (jnp.arange(nb), qb, cb))
    return o.transpose(1, 0, 3, 2, 4).reshape(bsz, seq, heads * dh)


def mem_attention(q, mem_n, w_mem_kv):
    bsz, seq, _ = q.shape
    k, v = split_cols(mem_n @ w_mem_kv, (MEM_WIDTH, MEM_WIDTH))
    k = k.reshape(bsz, -1, MEM_HEADS, MEM_HEAD_DIM)
    v = v.reshape(bsz, -1, MEM_HEADS, MEM_HEAD_DIM)
    qh = q.reshape(bsz, seq, MEM_HEADS, MEM_HEAD_DIM)
    s = jnp.einsum('bshd,bmhd->bhsm', qh, k).astype(jnp.float32) * (MEM_HEAD_DIM ** -0.5)
    p = jax.nn.softmax(s, axis=-1).astype(v.dtype)
    return jnp.einsum('bhsm,bmhd->bshd', p, v).reshape(bsz, seq, MEM_WIDTH)


def moe_swiglu(h, w_router, w_gate, w_up, w_down):
    logits = (h @ w_router).astype(jnp.float32)
    top_val, top_idx = lax.top_k(logits, TOP_K)
    top_w = jax.nn.softmax(top_val, axis=-1)
    gates = jnp.sum(jax.nn.one_hot(top_idx, N_EXPERTS, dtype=jnp.float32) * top_w[..., None],
                    axis=-2).astype(h.dtype)
    y = jnp.zeros_like(h)
    for e in range(N_EXPERTS):
        y = y + gates[..., e:e + 1] * swiglu(h, w_gate[e], w_up[e], w_down[e])
    return y


def setup_inputs(seed: int = 0) -> dict:
    key = jax.random.key(seed)
    ks = jax.random.split(key, 24)
    f32 = jnp.float32

    def nrm(k, shape, fan_in):
        return jax.random.normal(k, shape, f32) * (fan_in ** -0.5)

    def gain(k, shape):
        return 1.0 + 0.02 * jax.random.normal(k, shape, f32)

    return {
        'x': jax.random.normal(ks[0], (BATCH, SEQ, D_MODEL), f32),
        'mem': jax.random.normal(ks[1], (BATCH, N_MEM, D_MODEL), f32),
        'norm_mix': gain(ks[2], (DEPTH, D_MODEL)),
        'norm_mem': gain(ks[3], (DEPTH, D_MODEL)),
        'norm_ffn': gain(ks[4], (DEPTH, D_MODEL)),
        'norm_kv': gain(ks[5], (D_MODEL,)),
        'norm_final': gain(ks[6], (D_MODEL,)),
        'w_in_a': nrm(ks[7], (N_A_LAYERS, D_MODEL, A_IN_WIDTH), D_MODEL),
        'w_gla_gate2': nrm(ks[8], (N_A_LAYERS, GLA_GATE_RANK, GLA_KEY_WIDTH), GLA_GATE_RANK),
        'b_gla_gate2': 0.01 * jax.random.normal(ks[9], (N_A_LAYERS, GLA_KEY_WIDTH), f32),
        'gla_onorm': gain(ks[10], (N_A_LAYERS, GLA_DV)),
        'w_in_b': nrm(ks[11], (N_B_LAYERS, D_MODEL, B_IN_WIDTH), D_MODEL),
        'w_kv': nrm(ks[12], (D_MODEL, KV_WIDTH), D_MODEL),
        'b_forget': 3.0 + 0.5 * jax.random.normal(ks[13], (FOX_HEADS,), f32),
        'w_mem_kv': nrm(ks[14], (DEPTH, D_MODEL, 2 * MEM_WIDTH), D_MODEL),
        'w_out': nrm(ks[15], (DEPTH, MAIN_WIDTH + MEM_WIDTH, D_MODEL), MAIN_WIDTH + MEM_WIDTH),
        'w_ff_gate': nrm(ks[16], (N_DENSE, D_MODEL, D_FF), D_MODEL),
        'w_ff_up': nrm(ks[17], (N_DENSE, D_MODEL, D_FF), D_MODEL),
        'w_ff_down': nrm(ks[18], (N_DENSE, D_FF, D_MODEL), D_FF),
        'w_router': nrm(ks[19], (N_MOE, D_MODEL, N_EXPERTS), D_MODEL),
        'w_moe_gate': nrm(ks[20], (N_MOE, N_EXPERTS, D_MODEL, D_FF), D_MODEL),
        'w_moe_up': nrm(ks[21], (N_MOE, N_EXPERTS, D_MODEL, D_FF), D_MODEL),
        'w_moe_down': nrm(ks[22], (N_MOE, N_EXPERTS, D_FF, D_MODEL), D_FF),
    }


def reference(x, mem, norm_mix, norm_mem, norm_ffn, norm_kv, norm_final, w_in_a, w_gla_gate2,
              b_gla_gate2, gla_onorm, w_in_b, w_kv, b_forget, w_mem_kv, w_out, w_ff_gate, w_ff_up,
              w_ff_down, w_router, w_moe_gate, w_moe_up, w_moe_down):
    bsz, seq, _ = x.shape
    k_sh = v_sh = c_sh = None
    for layer in range(DEPTH):
        if layer == N_A_LAYERS:
            kvp = rmsnorm(x, norm_kv) @ w_kv
            k_sh, v_sh, f_logit = split_cols(kvp, (MAIN_WIDTH, MAIN_WIDTH, FOX_HEADS))
            k_sh = k_sh.reshape(bsz, seq, FOX_HEADS, FOX_HEAD_DIM)
            v_sh = v_sh.reshape(bsz, seq, FOX_HEADS, FOX_HEAD_DIM)
            log_f = jax.nn.log_sigmoid((f_logit + b_forget).astype(jnp.float32))
            c_sh = jnp.cumsum(log_f, axis=1).transpose(0, 2, 1)

        hn = rmsnorm(x, norm_mix[layer])
        mem_n = rmsnorm(mem, norm_mem[layer])
        if layer < N_A_LAYERS:
            i = layer
            q, k, v, r, glr, mq = split_cols(
                hn @ w_in_a[i],
                (GLA_KEY_WIDTH, GLA_KEY_WIDTH, MAIN_WIDTH, MAIN_WIDTH, GLA_GATE_RANK, MEM_WIDTH))
            log_a = jax.nn.log_sigmoid(
                (glr @ w_gla_gate2[i] + b_gla_gate2[i]).astype(jnp.float32)) / GLA_GATE_TAU
            o = gla_scan(
                q.reshape(bsz, seq, GLA_HEADS, GLA_DK) * (GLA_DK ** -0.5),
                k.reshape(bsz, seq, GLA_HEADS, GLA_DK),
                v.reshape(bsz, seq, GLA_HEADS, GLA_DV),
                log_a.reshape(bsz, seq, GLA_HEADS, GLA_DK))
            o = rmsnorm(o, gla_onorm[i]) * jax.nn.silu(r.reshape(bsz, seq, GLA_HEADS, GLA_DV))
            main = o.reshape(bsz, seq, MAIN_WIDTH)
        else:
            j = layer - N_A_LAYERS
            qf, mq = split_cols(hn @ w_in_b[j], (MAIN_WIDTH, MEM_WIDTH))
            main = fox_attention(qf.reshape(bsz, seq, FOX_HEADS, FOX_HEAD_DIM), k_sh, v_sh, c_sh)
        mixed = jnp.concatenate([main, mem_attention(mq, mem_n, w_mem_kv[layer])], axis=-1)
        x = x + mixed @ w_out[layer]

        hn = rmsnorm(x, norm_ffn[layer])
        f = layer // 2
        if layer % 2 == 0:
            x = x + swiglu(hn, w_ff_gate[f], w_ff_up[f], w_ff_down[f])
        else:
            x = x + moe_swiglu(hn, w_router[f], w_moe_gate[f], w_moe_up[f], w_moe_down[f])
    return rmsnorm(x, norm_final)
```

```cpp
#include <hip/hip_runtime.h>
#include <hip/hip_bf16.h>
#include <cstdio>
#include <cstdint>
#include <cmath>
namespace pg8 {
#define PG8_LAS __attribute__((address_space(3)))
typedef unsigned short bf16_t;
typedef short bf16x8 __attribute__((ext_vector_type(8)));
typedef float f32x4 __attribute__((ext_vector_type(4)));
typedef unsigned u32x4 __attribute__((ext_vector_type(4)));
constexpr int BM = 256, BK = 64, HALF = 128, HTB = HALF * BK * 2  , STAGE_BYTES = 8 * HTB, NXCD = 8, WGM = 8;

__host__ __device__ __forceinline__ int lds_byte(int r, int c) { const int st = (r >> 4) * 2 + (c >> 5), rr = r & 15, cc = c & 31, ob = rr * 64 + cc * 2; return st * 1024 + (ob ^ (((ob >> 9) & 1) << 5)); }
__host__ __device__ __forceinline__ void stage_rc(int b, int& R, int& C) { const int st = b / 1024, sb = b % 1024, swz = sb ^ (((sb >> 9) & 1) << 5); R = (st >> 1) * 16 + swz / 64; C = (st & 1) * 32 + (swz % 64) / 2; }
__host__ __device__ __forceinline__ int perm32(int rho) { const int n = rho >> 4, i = rho & 15; return 8 * (i >> 2) + 4 * n + (i & 3); }

struct Unit { int pm, pn, e; };
struct Gemm { const bf16_t* A; const bf16_t* Bt; int M, N, K, lda, ldb; size_t bes; };

struct StaticOrder {
    int nM, nN, nwg, G, c;
    __host__ __device__ void init(int M, int N, int G_, int c_) { nM = M / BM; nN = N / BM; nwg = nM * nN; G = G_; c = c_; }
    __host__ __device__ bool next(int i, Unit& u) const {
        const long L = (long)i * G + c; if (L >= nwg) return false;
        int wgid = (int)L; { const int q = nwg / NXCD, r = nwg % NXCD, xcd = wgid % NXCD, off = wgid / NXCD; wgid = (xcd < r ? xcd * (q + 1) : r * (q + 1) + (xcd - r) * q) + off; }
        const int nig = WGM * nN, gid = wgid / nig, fm = gid * WGM, gsz = (nM - fm) < WGM ? (nM - fm) : WGM;
        u.pm = fm + ((wgid % nig) % gsz); u.pn = (wgid % nig) / gsz; u.e = 0; return true;
    }
    __device__ __forceinline__ void a_ready(const Unit&) const {}
    __device__ __forceinline__ void done(const Unit&) const {}
};

__device__ __forceinline__ unsigned cvt_pk_bf16(float lo, float hi) { unsigned r; asm volatile("v_cvt_pk_bf16_f32 %0, %1, %2" : "=v"(r) : "v"(lo), "v"(hi)); return r; }
typedef float f32x2 __attribute__((ext_vector_type(2)));
struct EpiBf16 {
    static constexpr bool PERM = true, AFTER_DRAIN = false;
    bf16_t* O; int ldc; float* side; int side_pn;
    __device__ __forceinline__ void operator()(const f32x4 (&acc)[2][2][4][2], const Unit& u, int wr, int wc, int fr, int fq) const {
        const int row0 = u.pm * BM + wr * 64 + fr; const int col0 = u.pn * BM + wc * 32 + 8 * fq;
#pragma unroll
        for (int ai = 0; ai < 2; ++ai)
#pragma unroll
            for (int m = 0; m < 4; ++m) { bf16_t* rowp = O + (size_t)(row0 + ai * HALF + m * 16) * ldc + col0;
#pragma unroll
                for (int bj = 0; bj < 2; ++bj) { const f32x4 v0 = acc[ai][bj][m][0], v1 = acc[ai][bj][m][1];
                    u32x4 w; w.x = cvt_pk_bf16(v0[0], v0[1]); w.y = cvt_pk_bf16(v0[2], v0[3]); w.z = cvt_pk_bf16(v1[0], v1[1]); w.w = cvt_pk_bf16(v1[2], v1[3]);
                    *(u32x4*)(rowp + bj * HALF) = w; } }
        if (side != nullptr && u.pn == side_pn && wc == 0 && fq < 2) {
#pragma unroll
            for (int ai = 0; ai < 2; ++ai)
#pragma unroll
                for (int m = 0; m < 4; ++m) { float* sp = side + (size_t)(row0 + ai * HALF + m * 16) * 16 + 8 * fq;
                    *(f32x4*)(sp) = acc[ai][0][m][0]; *(f32x4*)(sp + 4) = acc[ai][0][m][1]; }
        }
    }
};
struct EpiResF32 {
    static constexpr bool PERM = false, AFTER_DRAIN = false;
    const float* base; float* out; int ldc;
    __device__ __forceinline__ void operator()(const f32x4 (&acc)[2][2][4][2], const Unit& u, int wr, int wc, int fr, int fq) const {
        const int row0 = u.pm * BM + wr * 64 + fr, col0 = u.pn * BM + wc * 32 + 4 * fq;
#pragma unroll
        for (int ai = 0; ai < 2; ++ai)
#pragma unroll
            for (int m = 0; m < 4; ++m) { const size_t off = (size_t)(row0 + ai * HALF + m * 16) * ldc + col0;
#pragma unroll
                for (int bj = 0; bj < 2; ++bj)
#pragma unroll
                    for (int n = 0; n < 2; ++n) { const f32x4 b = *(const f32x4*)(base + off + bj * HALF + n * 16); *(f32x4*)(out + off + bj * HALF + n * 16) = b + acc[ai][bj][m][n]; }
                if (m & 1) asm volatile("" ::: "memory"); }
    }
};
__device__ __forceinline__ float silu_f(float g) { return g * __builtin_amdgcn_rcpf(1.0f + __builtin_amdgcn_exp2f(-1.4426950408889634f * g)); }
struct EpiSwiGLU {
    static constexpr bool PERM = true, AFTER_DRAIN = false;
    bf16_t* H; int ldh;
    __device__ __forceinline__ void operator()(const f32x4 (&acc)[2][2][4][2], const Unit& u, int wr, int wc, int fr, int fq) const {
        const int row0 = u.pm * BM + wr * 64 + fr; const int col0 = u.pn * HALF + wc * 32 + 8 * fq;
#pragma unroll
        for (int ai = 0; ai < 2; ++ai)
#pragma unroll
            for (int m = 0; m < 4; ++m) { bf16_t* rowp = H + (size_t)(row0 + ai * HALF + m * 16) * ldh + col0;
                const f32x4 g0 = acc[ai][0][m][0], g1 = acc[ai][0][m][1], u0 = acc[ai][1][m][0], u1 = acc[ai][1][m][1];
                u32x4 w; w.x = cvt_pk_bf16(silu_f(g0[0]) * u0[0], silu_f(g0[1]) * u0[1]); w.y = cvt_pk_bf16(silu_f(g0[2]) * u0[2], silu_f(g0[3]) * u0[3]);
                w.z = cvt_pk_bf16(silu_f(g1[0]) * u1[0], silu_f(g1[1]) * u1[1]); w.w = cvt_pk_bf16(silu_f(g1[2]) * u1[2], silu_f(g1[3]) * u1[3]);
                *(u32x4*)rowp = w; }
    }
};
struct EpiScatter {
    static constexpr bool PERM = false, AFTER_DRAIN = false;
    const int* tok; const float* gate; float* out; int ldc;
    __device__ __forceinline__ void operator()(const f32x4 (&acc)[2][2][4][2], const Unit& u, int wr, int wc, int fr, int fq) const {
        const int row0 = u.pm * BM + wr * 64 + fr, col0 = u.pn * BM + wc * 32 + 4 * fq;
#pragma unroll
        for (int ai = 0; ai < 2; ++ai)
#pragma unroll
            for (int m = 0; m < 4; ++m) { const int r = row0 + ai * HALF + m * 16; const int t = tok[r]; const float gw = gate[r];
                if (t >= 0) { const size_t off = (size_t)t * ldc + col0;
#pragma unroll
                    for (int bj = 0; bj < 2; ++bj)
#pragma unroll
                        for (int n = 0; n < 2; ++n) { const f32x4 b = *(const f32x4*)(out + off + bj * HALF + n * 16); *(f32x4*)(out + off + bj * HALF + n * 16) = b + acc[ai][bj][m][n] * gw; } }
                if (m & 1) asm volatile("" ::: "memory"); }
    }
};
struct MoeOrder {
    StaticOrder so; const int* tile_e;
    __device__ void init(int nM, int N, int G_, int c_, const int* te) { so.nM = nM; so.nN = N / BM; so.nwg = nM * so.nN; so.G = G_; so.c = c_; tile_e = te; }
    __device__ bool next(int i, Unit& u) const { if (!so.next(i, u)) return false; u.e = __builtin_amdgcn_readfirstlane(tile_e[u.pm]); return true; }
    __device__ __forceinline__ void a_ready(const Unit&) const {}
    __device__ __forceinline__ void done(const Unit&) const {}
};
template <class Epi, class Sched, bool ALIGN_EPI = false, bool SP2 = false>
__device__ __forceinline__ void gemm_phase(PG8_LAS unsigned char* lds, const Gemm g, const Sched& S, const Epi& E) {
    const int tid = threadIdx.x, wid = __builtin_amdgcn_readfirstlane(tid >> 6), lane = tid & 63, wr = wid >> 2, wc = wid & 3, fr = lane & 15, fq = lane >> 4;
    const int K = g.K, nt = K / BK;
    unsigned voffA[2], voffB[2];
#pragma unroll
    for (int i = 0; i < 2; ++i) { int R, C; stage_rc(tid * 16 + i * 8192, R, C); const int Rb = Epi::PERM ? ((R & ~31) + perm32(R & 31)) : R;
        voffA[i] = (unsigned)(R * g.lda + C) * 2u; voffB[i] = (unsigned)(Rb * g.ldb + C) * 2u; }
    const size_t kstep = (size_t)(BK * 2);
    const size_t hstepA = (size_t)HALF * g.lda * 2, hstepB = (size_t)HALF * g.ldb * 2;
    const size_t tstepA = 2 * hstepA, tstepB = 2 * hstepB, estepB = g.bes * 2;
    const unsigned ldsw = (unsigned)wid * 1024u;
    const int aoff = lds_byte(wr * 64 + fr, fq * 8), boff = lds_byte(wc * 32 + fr, fq * 8);
#define PG8_SA(b, h) (((b) * 2 + (h)) * HTB)
#define PG8_SB(b, h) ((4 + (b) * 2 + (h)) * HTB)
#define PG8_STAGE(bufoff, gbase, voff) do { _Pragma("unroll") for (int _i = 0; _i < 2; ++_i) \
        __builtin_amdgcn_global_load_lds((const unsigned*)((const char*)(gbase) + (voff)[_i]), (PG8_LAS unsigned*)(lds + (bufoff) + ldsw + _i * 8192), 16, 0, 0); } while (0)
#define PG8_LDA(dst, b, h) do { _Pragma("unroll") for (int m = 0; m < 4; ++m) _Pragma("unroll") for (int k = 0; k < 2; ++k) dst[m][k] = *(const PG8_LAS bf16x8*)(lds + PG8_SA(b, h) + aoff + m * 2048 + k * 1024); } while (0)
#define PG8_LDB(dst, b, h) do { _Pragma("unroll") for (int n = 0; n < 2; ++n) _Pragma("unroll") for (int k = 0; k < 2; ++k) dst[n][k] = *(const PG8_LAS bf16x8*)(lds + PG8_SB(b, h) + boff + n * 2048 + k * 1024); } while (0)
#define PG8_MMA(ai, bj, At, Bt) do { __builtin_amdgcn_s_setprio(1); _Pragma("unroll") for (int m = 0; m < 4; ++m) _Pragma("unroll") for (int n = 0; n < 2; ++n) _Pragma("unroll") for (int k = 0; k < 2; ++k) \
        acc[ai][bj][m][n] = __builtin_amdgcn_mfma_f32_16x16x32_bf16(Bt[n][k], At[m][k], acc[ai][bj][m][n], 0, 0, 0); __builtin_amdgcn_s_setprio(0); } while (0)
#define PG8_WAIT_V(n) asm volatile("s_waitcnt vmcnt(" #n ")" ::: "memory")
#define PG8_WAIT_L(n) asm volatile("s_waitcnt lgkmcnt(" #n ")" ::: "memory")
#define PG8_BAR __builtin_amdgcn_s_barrier()
#define PG8_SCHED __builtin_amdgcn_sched_barrier(0)
    Unit cur, nxt; int ui = 0;
    if (!S.next(0, cur)) return;
    f32x4 acc[2][2][4][2];
#pragma unroll
    for (int a = 0; a < 2; ++a)
#pragma unroll
        for (int b = 0; b < 2; ++b)
#pragma unroll
            for (int m = 0; m < 4; ++m)
#pragma unroll
                for (int n = 0; n < 2; ++n) acc[a][b][m][n] = (f32x4){0.f, 0.f, 0.f, 0.f};
    bf16x8 At[4][2], B0[2][2], B1[2][2];
    const char* cA = (const char*)g.A + (size_t)cur.pm * tstepA; const char* cB = (const char*)g.Bt + (size_t)cur.e * estepB + (size_t)cur.pn * tstepB;
    S.a_ready(cur);
    if constexpr (SP2) {
        PG8_STAGE(PG8_SB(0, 0), cB, voffB); PG8_STAGE(PG8_SB(0, 1), cB + hstepB, voffB); PG8_STAGE(PG8_SA(0, 0), cA, voffA); PG8_STAGE(PG8_SA(0, 1), cA + hstepA, voffA);
        if (wr == 1) PG8_BAR;
        PG8_WAIT_V(2); PG8_BAR;
        PG8_STAGE(PG8_SB(1, 0), cB + kstep, voffB); PG8_STAGE(PG8_SA(1, 0), cA + kstep, voffA); PG8_STAGE(PG8_SB(1, 1), cB + hstepB + kstep, voffB);
        PG8_WAIT_V(6); PG8_BAR;
    } else {
        PG8_STAGE(PG8_SB(0, 0), cB, voffB); PG8_STAGE(PG8_SA(0, 0), cA, voffA); PG8_STAGE(PG8_SB(0, 1), cB + hstepB, voffB); PG8_STAGE(PG8_SA(0, 1), cA + hstepA, voffA);
        if (wr == 1) PG8_BAR;
        PG8_WAIT_V(4); PG8_BAR;
        PG8_STAGE(PG8_SB(1, 0), cB + kstep, voffB); PG8_STAGE(PG8_SA(1, 0), cA + kstep, voffA); PG8_STAGE(PG8_SB(1, 1), cB + hstepB + kstep, voffB);
        PG8_WAIT_V(6); PG8_BAR;
    }
    for (;;) {
        const bool has_next = S.next(ui + 1, nxt);
        const char* nA = has_next ? (const char*)g.A + (size_t)nxt.pm * tstepA : cA; const char* nB = has_next ? (const char*)g.Bt + (size_t)nxt.e * estepB + (size_t)nxt.pn * tstepB : cB;
        for (int t = 0; t < nt; t += 2) {
            const bool last = (t == nt - 2);
            const char* a1 = cA + (size_t)(t + 1) * kstep;
            const char* a2 = last ? nA : cA + (size_t)(t + 2) * kstep; const char* b2 = last ? nB : cB + (size_t)(t + 2) * kstep;
            const char* a3 = a2 + kstep; const char* b3 = b2 + kstep;
            if (last && has_next) S.a_ready(nxt);
            if constexpr (SP2) {
            PG8_LDB(B0, 0, 0); PG8_LDB(B1, 0, 1); PG8_SCHED; PG8_LDA(At, 0, 0); PG8_STAGE(PG8_SA(1, 1), a1 + hstepA, voffA);
            PG8_WAIT_V(8); PG8_WAIT_L(0); PG8_BAR; PG8_MMA(0, 0, At, B0); PG8_MMA(0, 1, At, B1); PG8_BAR; PG8_SCHED;
            PG8_LDA(At, 0, 1); PG8_STAGE(PG8_SB(0, 0), b2, voffB); PG8_STAGE(PG8_SB(0, 1), b2 + hstepB, voffB); PG8_STAGE(PG8_SA(0, 0), a2, voffA);
            PG8_WAIT_V(8); PG8_WAIT_L(0); PG8_BAR; PG8_MMA(1, 0, At, B0); PG8_MMA(1, 1, At, B1); PG8_BAR; PG8_SCHED;
            PG8_LDB(B0, 1, 0); PG8_LDB(B1, 1, 1); PG8_SCHED; PG8_LDA(At, 1, 0); PG8_STAGE(PG8_SA(0, 1), a2 + hstepA, voffA);
            PG8_WAIT_V(8); PG8_WAIT_L(0); PG8_BAR; PG8_MMA(0, 0, At, B0); PG8_MMA(0, 1, At, B1); PG8_BAR; PG8_SCHED;
            PG8_LDA(At, 1, 1); PG8_STAGE(PG8_SB(1, 0), b3, voffB); PG8_STAGE(PG8_SB(1, 1), b3 + hstepB, voffB); PG8_STAGE(PG8_SA(1, 0), a3, voffA);
            PG8_WAIT_V(8); PG8_WAIT_L(0); PG8_BAR; PG8_MMA(1, 0, At, B0); PG8_MMA(1, 1, At, B1); PG8_BAR; PG8_SCHED;
            } else {
            PG8_LDB(B0, 0, 0); PG8_SCHED; PG8_LDA(At, 0, 0); PG8_STAGE(PG8_SA(1, 1), a1 + hstepA, voffA);
            PG8_WAIT_L(8); PG8_BAR; PG8_WAIT_L(0); PG8_MMA(0, 0, At, B0); PG8_BAR; PG8_SCHED;
            PG8_LDB(B1, 0, 1); PG8_STAGE(PG8_SB(0, 0), b2, voffB);
            PG8_BAR; PG8_WAIT_L(0); PG8_MMA(0, 1, At, B1); PG8_BAR;
            PG8_LDA(At, 0, 1); PG8_STAGE(PG8_SA(0, 0), a2, voffA);
            PG8_BAR; PG8_WAIT_L(0); PG8_MMA(1, 0, At, B0); PG8_BAR; PG8_SCHED;
            PG8_STAGE(PG8_SB(0, 1), b2 + hstepB, voffB);
            PG8_WAIT_V(6); PG8_BAR; PG8_MMA(1, 1, At, B1); PG8_BAR;
            PG8_LDB(B0, 1, 0); PG8_SCHED; PG8_LDA(At, 1, 0); PG8_STAGE(PG8_SA(0, 1), a2 + hstepA, voffA);
            PG8_WAIT_L(8); PG8_BAR; PG8_WAIT_L(0); PG8_MMA(0, 0, At, B0); PG8_BAR; PG8_SCHED;
            PG8_LDB(B1, 1, 1); PG8_STAGE(PG8_SB(1, 0), b3, voffB);
            PG8_BAR; PG8_WAIT_L(0); PG8_MMA(0, 1, At, B1); PG8_BAR;
            PG8_LDA(At, 1, 1); PG8_STAGE(PG8_SA(1, 0), a3, voffA);
            PG8_BAR; PG8_WAIT_L(0); PG8_MMA(1, 0, At, B0); PG8_BAR; PG8_SCHED;
            PG8_STAGE(PG8_SB(1, 1), b3 + hstepB, voffB);
            PG8_WAIT_V(6); PG8_BAR; PG8_MMA(1, 1, At, B1); PG8_BAR;
            }
        }
        if constexpr (ALIGN_EPI) { if (wr == 0) PG8_BAR; }
        if constexpr (!Epi::AFTER_DRAIN) { E(acc, cur, wr, wc, fr, fq); S.done(cur); }
        if (!has_next) break;
#pragma unroll
        for (int a = 0; a < 2; ++a)
#pragma unroll
            for (int b = 0; b < 2; ++b)
#pragma unroll
                for (int m = 0; m < 4; ++m)
#pragma unroll
                    for (int n = 0; n < 2; ++n) acc[a][b][m][n] = (f32x4){0.f, 0.f, 0.f, 0.f};
        cur = nxt; cA = nA; cB = nB; ++ui;
        if constexpr (ALIGN_EPI) { if (wr == 1) PG8_BAR; }
    }
    PG8_WAIT_V(0);
    if constexpr (!ALIGN_EPI) { if (wr == 0) PG8_BAR; }
    PG8_BAR;
    if constexpr (Epi::AFTER_DRAIN) { E.fused(acc, cur, wr, wc, fr, fq, lds, wid, lane); S.done(cur); }
#undef PG8_SA
#undef PG8_SB
#undef PG8_STAGE
#undef PG8_LDA
#undef PG8_LDB
#undef PG8_MMA
#undef PG8_WAIT_V
#undef PG8_WAIT_L
#undef PG8_BAR
#undef PG8_SCHED
}
}
#include <hip/hip_bf16.h>
#include <cmath>
namespace attn_body {
using bf16=__hip_bfloat16;
using bf16x8=__attribute__((ext_vector_type(8)))short;
using s16x4=__attribute__((ext_vector_type(4)))short;
using f32x16=__attribute__((ext_vector_type(16)))float;
using u32x4=__attribute__((ext_vector_type(4)))unsigned;
constexpr int D=64;
constexpr int NW=8,QBLK=32,QB=QBLK*NW,KVBLK=64;
constexpr int ATTN_UNIT_ROWS=QB;
__device__ __forceinline__ int crow(int r,int hi){return (r&3)+8*(r>>2)+4*hi;}
#define SBAR() __builtin_amdgcn_sched_barrier(0)
__device__ __forceinline__ void cmask(f32x16&p0,f32x16&p1,int jb,int qrel,int hi){
  const float NEG=-INFINITY; int kb=64*jb+4*hi;
  #pragma unroll
  for(int r=0;r<16;++r){int kv=kb+(r&3)+8*(r>>2); if(kv>qrel)p0[r]=NEG; if(kv+32>qrel)p1[r]=NEG;}
}

constexpr int NSLOT=3, SLOTB=8192;
constexpr int LDS_K=0, LDS_V=NSLOT*SLOTB, LDS_WS=2*NSLOT*SLOTB, LDS_OST=LDS_WS+NW*64*4, LDS_BYTES=LDS_OST+NW*4096;
constexpr float C2=0.125f*1.4426950408889634f;
__device__ __forceinline__ void glds16(const void*gsrc,unsigned lds_dst){unsigned keep;
  asm volatile("s_mov_b32 %0, m0\n\ts_mov_b32 m0, %2\n\ts_nop 0\n\tglobal_load_lds_dwordx4 %1, off\n\ts_mov_b32 m0, %0":"=&s"(keep):"v"(gsrc),"s"(lds_dst):"memory");}
__device__ __forceinline__ float max3f(float a,float b,float c){float r;asm("v_max3_f32 %0, %1, %2, %3":"=v"(r):"v"(a),"v"(b),"v"(c));return r;}
__device__ __forceinline__ float max2f(float a,float b){float r;asm("v_max_f32_e32 %0, %1, %2":"=v"(r):"v"(a),"v"(b));return r;}
__device__ __forceinline__ float fadd_s(float a,float b){float r;asm("v_add_f32_e32 %0, %1, %2":"=v"(r):"v"(a),"v"(b));return r;}
__device__ __forceinline__ float fsub_s(float a,float b){float r;asm("v_sub_f32_e32 %0, %1, %2":"=v"(r):"v"(a),"v"(b));return r;}
typedef float f32x2_t __attribute__((ext_vector_type(2))); typedef __bf16 bf16x2_t __attribute__((ext_vector_type(2)));
__device__ __forceinline__ unsigned cvtpk_s(float lo,float hi){f32x2_t v={lo,hi};bf16x2_t b=__builtin_convertvector(v,bf16x2_t);return __builtin_bit_cast(unsigned,b);}
#define WAIT_BAR(N) asm volatile("s_waitcnt vmcnt(" #N ") lgkmcnt(0)\n\ts_barrier":::"memory")

__device__ __forceinline__ void qkt(f32x16&p0,f32x16&p1,const char*Kslot,const bf16x8*qr,const f32x16&negm,int r32,int hi){
  const char*kb=Kslot+hi*1024+r32*16;
  #pragma unroll
  for(int d0=0;d0<4;++d0){
    const bf16x8 b0=*reinterpret_cast<const bf16x8*>(kb+d0*2048);
    const bf16x8 b1=*reinterpret_cast<const bf16x8*>(kb+d0*2048+512);
    if(d0==0){p0=__builtin_amdgcn_mfma_f32_32x32x16_bf16(b0,qr[0],negm,0,0,0);p1=__builtin_amdgcn_mfma_f32_32x32x16_bf16(b1,qr[0],negm,0,0,0);}
    else{p0=__builtin_amdgcn_mfma_f32_32x32x16_bf16(b0,qr[d0],p0,0,0,0);p1=__builtin_amdgcn_mfma_f32_32x32x16_bf16(b1,qr[d0],p1,0,0,0);}}
}
typedef __attribute__((address_space(3))) const char* lds_cptr;
typedef short v4i16_t __attribute__((ext_vector_type(4)));
__device__ __forceinline__ void kload8(bf16x8*kf,lds_cptr kp){
  kf[0]=*(const __attribute__((address_space(3))) bf16x8*)(kp);      kf[1]=*(const __attribute__((address_space(3))) bf16x8*)(kp+512);
  kf[2]=*(const __attribute__((address_space(3))) bf16x8*)(kp+2048); kf[3]=*(const __attribute__((address_space(3))) bf16x8*)(kp+2560);
  kf[4]=*(const __attribute__((address_space(3))) bf16x8*)(kp+4096); kf[5]=*(const __attribute__((address_space(3))) bf16x8*)(kp+4608);
  kf[6]=*(const __attribute__((address_space(3))) bf16x8*)(kp+6144); kf[7]=*(const __attribute__((address_space(3))) bf16x8*)(kp+6656);
}
__device__ __forceinline__ void kload2(bf16x8*kf,lds_cptr kp,int j){ kf[2*j]=*(const __attribute__((address_space(3))) bf16x8*)(kp+j*2048); kf[2*j+1]=*(const __attribute__((address_space(3))) bf16x8*)(kp+j*2048+512); }
__device__ __forceinline__ s16x4 vtr(lds_cptr p){ return __builtin_bit_cast(s16x4,__builtin_amdgcn_ds_read_tr16_b64_v4i16((__attribute__((address_space(3))) v4i16_t*)p)); }
__device__ __forceinline__ float rowmax(const f32x16&p0,const f32x16&p1){
  float a=max3f(p0[0],p0[1],p1[0]),b=max3f(p0[2],p0[3],p1[1]);a=max3f(a,p1[2],p1[3]);
  #pragma unroll
  for(int r=4;r<16;r+=4){a=max3f(a,p0[r],p0[r+1]);b=max3f(b,p0[r+2],p0[r+3]);a=max3f(a,p1[r],p1[r+1]);b=max3f(b,p1[r+2],p1[r+3]);}
  const float m=max2f(a,b);
  auto rr=__builtin_amdgcn_permlane32_swap(__float_as_uint(m),__float_as_uint(m),false,false);
  return max2f(__uint_as_float(rr[0]),__uint_as_float(rr[1]));
}
__device__ __forceinline__ void pv(f32x16*o,int vb,bf16x8 pa0,bf16x8 pa1,bf16x8 pa2,bf16x8 pa3){
  #pragma unroll
  for(int d0=0;d0<2;++d0){s16x4 lo[4],hi[4];
    #pragma unroll
    for(int ks=0;ks<4;++ks){
      asm volatile("ds_read_b64_tr_b16 %0,%1 offset:%c2":"=&v"(lo[ks]):"v"(vb),"i"(d0*4096+ks*1024):"memory");
      asm volatile("ds_read_b64_tr_b16 %0,%1 offset:%c2":"=&v"(hi[ks]):"v"(vb),"i"(d0*4096+ks*1024+512):"memory");}
    asm volatile("s_waitcnt lgkmcnt(0)":::"memory");SBAR();
    #define PK(k) (bf16x8){lo[k][0],lo[k][1],lo[k][2],lo[k][3],hi[k][0],hi[k][1],hi[k][2],hi[k][3]}
    o[d0]=__builtin_amdgcn_mfma_f32_32x32x16_bf16(pa0,PK(0),o[d0],0,0,0);
    o[d0]=__builtin_amdgcn_mfma_f32_32x32x16_bf16(pa1,PK(1),o[d0],0,0,0);
    o[d0]=__builtin_amdgcn_mfma_f32_32x32x16_bf16(pa2,PK(2),o[d0],0,0,0);
    o[d0]=__builtin_amdgcn_mfma_f32_32x32x16_bf16(pa3,PK(3),o[d0],0,0,0);
    #undef PK
  }
}

#ifndef ATTN_STORE16
#define ATTN_STORE16(p,v) (*(u32x4*)(p)=(v))
#endif
template<int THRL,bool CAUSAL,bool FOX,int PQ,int PK> __device__ __forceinline__ void attn_unit(long qrow,long kvrow,int NT,const bf16*Q,const bf16*__restrict__ K,const bf16*__restrict__ V,bf16*O,const float*cs,char*shm){
  const int tid=threadIdx.x,lane=tid&63,r32=lane&31,hi=lane>>5; const int wid=__builtin_amdgcn_readfirstlane(tid>>6);
  const bf16*Qw=Q+(qrow+wid*QBLK)*PQ;
  const bf16*Kh=K+kvrow*PK,*Vh=V+kvrow*PK;
  const unsigned lds0=(unsigned)(uintptr_t)shm;
  float*wsf=(float*)(shm+LDS_WS)+wid*64;
  const bf16*ksrc=Kh+(long)lane*PK+wid*8;
  const bf16*vsrc=Vh+(long)(16*(wid&3)+(lane>>2))*PK+(wid>>2)*32+(lane&3)*8;
  const unsigned kdst=lds0+LDS_K+wid*1024, vdst=lds0+LDS_V+wid*1024;
  #define DMA_K(t,slot) glds16(ksrc+(long)(t)*KVBLK*PK,(unsigned)__builtin_amdgcn_readfirstlane(kdst+(slot)))
  #define DMA_V(t,slot) glds16(vsrc+(long)(t)*KVBLK*PK,(unsigned)__builtin_amdgcn_readfirstlane(vdst+(slot)))
  const int vb0=(int)(lds0+LDS_V)+((lane>>4)&1)*32+(lane&3)*8+(4*hi+((lane&15)>>2))*64;
  const char*Kbase=shm+LDS_K; bf16x8 kf[8];
  const lds_cptr shm3=(lds_cptr)shm; const lds_cptr kp0=shm3+LDS_K+hi*1024+r32*16; const lds_cptr vp0=shm3+LDS_V+((lane>>4)&1)*32+(lane&3)*8+(4*hi+((lane&15)>>2))*64;
  typedef __attribute__((address_space(3))) float lds_f32; typedef float f32x4_t __attribute__((ext_vector_type(4)));
  const __attribute__((address_space(3))) f32x4_t* csl=(const __attribute__((address_space(3))) f32x4_t*)(shm3+LDS_BYTES);
  if(FOX){ __attribute__((address_space(3))) f32x4_t* d=(__attribute__((address_space(3))) f32x4_t*)(shm3+LDS_BYTES); const f32x4_t* s=(const f32x4_t*)cs; for(int i=tid;i<NT*16;i+=NW*64)d[i]=s[i]; }
  #define CINIT(P0,P1,t) do{ if(FOX){ const __attribute__((address_space(3))) f32x4_t* cp_=csl+16*(t)+hi; const float nm_=-mhat; \
    _Pragma("unroll") for(int j_=0;j_<4;++j_){ const f32x4_t a_=cp_[2*j_], b_=cp_[8+2*j_]; \
      P0[4*j_]=nm_-a_[0];P0[4*j_+1]=nm_-a_[1];P0[4*j_+2]=nm_-a_[2];P0[4*j_+3]=nm_-a_[3]; P1[4*j_]=nm_-b_[0];P1[4*j_+1]=nm_-b_[1];P1[4*j_+2]=nm_-b_[2];P1[4*j_+3]=nm_-b_[3]; } } }while(0)
  #define FBIAS(P0,P1,t) do{ if(FOX){ const __attribute__((address_space(3))) f32x4_t* cp_=csl+16*(t)+hi; \
    _Pragma("unroll") for(int j_=0;j_<4;++j_){ const f32x4_t a_=cp_[2*j_], b_=cp_[8+2*j_]; \
      P0[4*j_]-=a_[0];P0[4*j_+1]-=a_[1];P0[4*j_+2]-=a_[2];P0[4*j_+3]-=a_[3]; P1[4*j_]-=b_[0];P1[4*j_+1]-=b_[1];P1[4*j_+2]-=b_[2];P1[4*j_+3]-=b_[3]; } } }while(0)
  DMA_K(0,0);DMA_V(0,0);DMA_K(1,SLOTB);
  bf16x8 qr[4];
  #pragma unroll
  for(int d0=0;d0<4;++d0)qr[d0]=*reinterpret_cast<const bf16x8*>(&Qw[(long)r32*PQ+d0*16+hi*8]);
  float mhat=0.f,l_reg=0.f;f32x16 o[2];o[0]=f32x16{};o[1]=f32x16{};f32x16 negm=f32x16{};asm volatile("":"+v"(negm));
  const int qrel=wid*QBLK+r32;
  #define CMASK(P0,P1,t) do{ if(CAUSAL){int jb_=(t)-(NT-4); if(jb_>=0)cmask(P0,P1,jb_,qrel,hi);} }while(0)
  bool resc=false;
  #define START(P0,P1) do{ const float rm=rowmax(P0,P1); resc=false; \
    { const float dl=rm; mhat=fadd_s(mhat,dl); \
      _Pragma("unroll") for(int r=0;r<16;++r){P0[r]=fsub_s(P0[r],dl);P1[r]=fsub_s(P1[r],dl);} \
      _Pragma("unroll") for(int r=0;r<16;++r)negm[r]=-mhat; asm volatile("":"+v"(negm)); } \
    _Pragma("unroll") for(int r=0;r<16;++r)P0[r]=__builtin_amdgcn_exp2f(P0[r]); }while(0)
  #define RESC() do{ if(resc){ asm volatile("s_waitcnt lgkmcnt(0)":::"memory"); \
      _Pragma("unroll") for(int d_=0;d_<2;++d_) _Pragma("unroll") for(int r=0;r<16;++r)o[d_][r]*=wsf[crow(r,hi)]; } }while(0)
  f32x16 pA0,pA1,pB0,pB1;
  int sl_prev=0,sl_cur=0,sl_next=SLOTB;
  #define ROT() do{sl_prev=sl_cur;sl_cur=sl_next;sl_next=(sl_next==(NSLOT-1)*SLOTB)?0:sl_next+SLOTB;}while(0)
  DMA_K(2,2*SLOTB);
  WAIT_BAR(3);
  qkt(pA0,pA1,Kbase,qr,negm,r32,hi);asm volatile("s_nop 15\n\ts_nop 7":"+v"(pA0),"+v"(pA1));FBIAS(pA0,pA1,0);CMASK(pA0,pA1,0);
  START(pA0,pA1);
  _Pragma("unroll") for(int r=0;r<16;++r)pA1[r]=__builtin_amdgcn_exp2f(pA1[r]);
  WAIT_BAR(0);
  DMA_K(3,0);DMA_V(1,SLOTB);
  ROT();
  kload8(kf,kp0+sl_cur);
  WAIT_BAR(2);
  s16x4 vlo[8],vhi[8]; u32x4 pw0,pw1,pw2,pw3;
  #define PKW(P,B) cvtpk_s(P[B],P[B+1])
  #define PAF(k) __builtin_bit_cast(bf16x8,pw##k)
  #define VFR(i) (bf16x8){vlo[i][0],vlo[i][1],vlo[i][2],vlo[i][3],vhi[i][0],vhi[i][1],vhi[i][2],vhi[i][3]}
  #define PIN(x) asm volatile("":"+v"(x))
  #define MX3(a,b,c) __builtin_fmaxf(__builtin_fmaxf((a),(b)),(c))
  #define GAPA(MF,A0,A1,A2,A3,W0,W1,PW) do{ MF; sacc+=A0; sacc+=A1; sacc+=A2; sacc+=A3; PIN(sacc); W0; W1; PIN(PW); SBAR(); }while(0)
  #define EX(v) __builtin_amdgcn_exp2f(v)
  #define GAPB(MF,X,B) do{ MF; X[B]=EX(X[B]); X[B+1]=EX(X[B+1]); X[B+2]=EX(X[B+2]); X[B+3]=EX(X[B+3]); PIN(X); SBAR(); }while(0)
  #define VRD(i) do{ vlo[i]=vtr(vp_+(((i)>>2)*4096+((i)&3)*1024)); vhi[i]=vtr(vp_+(((i)>>2)*4096+((i)&3)*1024+512)); }while(0)
  #define KRD(G,j) do{ if(G){ kload2(kf,kp0+sl_next,j); SBAR(); } }while(0)
  #define STEP(C0,C1,P0,P1,t,GK,GV,GL) do{ SBAR(); CINIT(C0,C1,t); SBAR(); \
    const lds_cptr vp_=vp0+sl_prev; \
    VRD(0); SBAR(); float sacc=(P0[0]+P0[1]); \
    GAPA(C0=__builtin_amdgcn_mfma_f32_32x32x16_bf16(kf[0],qr[0],(FOX?C0:negm),0,0,0), P0[2],P0[3],P0[4],P0[5],     pw0[0]=PKW(P0,0), pw0[1]=PKW(P0,2), pw0); \
    VRD(4); SBAR(); GAPA(C1=__builtin_amdgcn_mfma_f32_32x32x16_bf16(kf[1],qr[0],(FOX?C1:negm),0,0,0), P0[6],P0[7],P0[8],P0[9],     pw0[2]=PKW(P0,4), pw0[3]=PKW(P0,6), pw0); \
    VRD(1); SBAR(); GAPA(C0=__builtin_amdgcn_mfma_f32_32x32x16_bf16(kf[2],qr[1],C0,0,0,0),   P0[10],P0[11],P0[12],P0[13], pw1[0]=PKW(P0,8), pw1[1]=PKW(P0,10), pw1); \
    VRD(5); SBAR(); GAPA(C1=__builtin_amdgcn_mfma_f32_32x32x16_bf16(kf[3],qr[1],C1,0,0,0),   P0[14],P0[15],P1[0],P1[1],   pw1[2]=PKW(P0,12),pw1[3]=PKW(P0,14), pw1); \
    VRD(2); SBAR(); GAPA(C0=__builtin_amdgcn_mfma_f32_32x32x16_bf16(kf[4],qr[2],C0,0,0,0),   P1[2],P1[3],P1[4],P1[5],     pw2[0]=PKW(P1,0), pw2[1]=PKW(P1,2), pw2); \
    VRD(6); SBAR(); GAPA(C1=__builtin_amdgcn_mfma_f32_32x32x16_bf16(kf[5],qr[2],C1,0,0,0),   P1[6],P1[7],P1[8],P1[9],     pw2[2]=PKW(P1,4), pw2[3]=PKW(P1,6), pw2); \
    VRD(3); SBAR(); GAPA(C0=__builtin_amdgcn_mfma_f32_32x32x16_bf16(kf[6],qr[3],C0,0,0,0),   P1[10],P1[11],P1[12],P1[13], pw3[0]=PKW(P1,8), pw3[1]=PKW(P1,10), pw3); \
    VRD(7); SBAR(); GAPA(C1=__builtin_amdgcn_mfma_f32_32x32x16_bf16(kf[7],qr[3],C1,0,0,0),   P1[14],P1[15],0.f,0.f,       pw3[2]=PKW(P1,12),pw3[3]=PKW(P1,14), pw3); \
    l_reg+=sacc; \
    if(GK){DMA_K((t)+3,sl_cur);} if(GV){DMA_V((t)+1,sl_next);} \
    CMASK(C0,C1,t); \
    { float a=MX3(C0[0],C0[1],C1[0]),b=MX3(C0[2],C0[3],C1[1]); a=MX3(a,C1[2],C1[3]); \
      _Pragma("unroll") for(int r=4;r<16;r+=4){a=MX3(a,C0[r],C0[r+1]);b=MX3(b,C0[r+2],C0[r+3]);a=MX3(a,C1[r],C1[r+1]);b=MX3(b,C1[r+2],C1[r+3]);} \
      float rm=__builtin_fmaxf(a,b); { auto rr=__builtin_amdgcn_permlane32_swap(__float_as_uint(rm),__float_as_uint(rm),false,false); rm=__builtin_fmaxf(__uint_as_float(rr[0]),__uint_as_float(rr[1])); } \
      resc=false; \
      if(__builtin_expect(__any(rm>(float)THRL),0)){ const float dl=__builtin_fmaxf(rm,0.f); mhat+=dl; \
        _Pragma("unroll") for(int r=0;r<16;++r){C0[r]-=dl;C1[r]-=dl;} \
        _Pragma("unroll") for(int r=0;r<16;++r)negm[r]=-mhat; asm volatile("":"+v"(negm)); \
        const float f=__builtin_amdgcn_exp2f(-dl); l_reg*=f; if(hi==0)wsf[r32]=f; resc=true; } } \
    SBAR(); \
    GAPB(o[0]=__builtin_amdgcn_mfma_f32_32x32x16_bf16(PAF(0),VFR(0),o[0],0,0,0), C0,0); \
    GAPB(o[1]=__builtin_amdgcn_mfma_f32_32x32x16_bf16(PAF(0),VFR(4),o[1],0,0,0), C0,4); \
    KRD(GL,0); GAPB(o[0]=__builtin_amdgcn_mfma_f32_32x32x16_bf16(PAF(1),VFR(1),o[0],0,0,0), C0,8); \
    KRD(GL,1); GAPB(o[1]=__builtin_amdgcn_mfma_f32_32x32x16_bf16(PAF(1),VFR(5),o[1],0,0,0), C0,12); \
    KRD(GL,2); GAPB(o[0]=__builtin_amdgcn_mfma_f32_32x32x16_bf16(PAF(2),VFR(2),o[0],0,0,0), C1,0); \
    KRD(GL,3); GAPB(o[1]=__builtin_amdgcn_mfma_f32_32x32x16_bf16(PAF(2),VFR(6),o[1],0,0,0), C1,4); \
    GAPB(o[0]=__builtin_amdgcn_mfma_f32_32x32x16_bf16(PAF(3),VFR(3),o[0],0,0,0), C1,8); \
    GAPB(o[1]=__builtin_amdgcn_mfma_f32_32x32x16_bf16(PAF(3),VFR(7),o[1],0,0,0), C1,12); \
    }while(0)
  int t=1;
  #undef CMASK
  #define CMASK(P0,P1,t) do{}while(0)
  for(;t+5<NT;t+=2){
    STEP(pB0,pB1,pA0,pA1,t,true,true,true);     WAIT_BAR(2); RESC(); ROT();
    STEP(pA0,pA1,pB0,pB1,t+1,true,true,true);   WAIT_BAR(2); RESC(); ROT();
  }
  #undef CMASK
  #define CMASK(P0,P1,t) do{ if(CAUSAL){int jb_=(t)-(NT-4); if(jb_>=0)cmask(P0,P1,jb_,qrel,hi);} }while(0)
  #define ENDW(tt) do{ if((tt)+3<NT){WAIT_BAR(2);} else if((tt)+2<NT){WAIT_BAR(1);} else {WAIT_BAR(0);} }while(0)
  for(;t+1<NT;t+=2){
    STEP(pB0,pB1,pA0,pA1,t,(t+3<NT),(t+1<NT),(t+1<NT));       ENDW(t);   RESC(); ROT();
    STEP(pA0,pA1,pB0,pB1,t+1,(t+4<NT),(t+2<NT),(t+2<NT));     ENDW(t+1); RESC(); ROT();
  }
  STEP(pB0,pB1,pA0,pA1,NT-1,false,false,false); RESC();
  { float sacc=pB0[0]+pB0[1]; _Pragma("unroll") for(int r=2;r<16;++r)sacc+=pB0[r]; _Pragma("unroll") for(int r=0;r<16;++r)sacc+=pB1[r]; l_reg+=sacc;
    pw0=(u32x4){PKW(pB0,0),PKW(pB0,2),PKW(pB0,4),PKW(pB0,6)};pw1=(u32x4){PKW(pB0,8),PKW(pB0,10),PKW(pB0,12),PKW(pB0,14)};pw2=(u32x4){PKW(pB1,0),PKW(pB1,2),PKW(pB1,4),PKW(pB1,6)};pw3=(u32x4){PKW(pB1,8),PKW(pB1,10),PKW(pB1,12),PKW(pB1,14)};
    SBAR(); pv(o,vb0+sl_cur,PAF(0),PAF(1),PAF(2),PAF(3)); }
  #undef PKW
  #undef PAF
  #undef VFR
  #undef PIN
  #undef MX3
  #undef GAPA
  #undef GAPB
  #undef EX
  #undef VRD
  #undef KRD
  #undef STEP
  #undef ENDW
  {auto rr=__builtin_amdgcn_permlane32_swap(__float_as_uint(l_reg),__float_as_uint(l_reg),false,false);l_reg=__uint_as_float(rr[0])+__uint_as_float(rr[1]);}
  if(hi==0)wsf[32+r32]=l_reg;asm volatile("s_waitcnt lgkmcnt(0)":::"memory");
  float rli[16];
  #pragma unroll
  for(int r=0;r<16;++r)rli[r]=__builtin_amdgcn_rcpf(wsf[32+crow(r,hi)]);
  bf16*Ow=O+(qrow+wid*QBLK)*PQ;
  { bf16*stg=(bf16*)(shm+LDS_OST)+wid*2048;
    #pragma unroll
    for(int r=0;r<16;++r){const int orow=crow(r,hi);
      #pragma unroll
      for(int d0=0;d0<2;++d0)stg[orow*64+d0*32+r32]=__float2bfloat16(o[d0][r]*rli[r]);}
    asm volatile("s_waitcnt lgkmcnt(0)":::"memory");
    #pragma unroll
    for(int i=0;i<4;++i){const int row=i*8+(lane>>3),ch=lane&7; const u32x4 v=*(const u32x4*)(stg+row*64+ch*8); ATTN_STORE16(Ow+(long)row*PQ+ch*8,v);} }
  asm volatile("s_waitcnt lgkmcnt(0)\n\ts_barrier":::"memory");
  #undef DMA_K
  #undef DMA_V
  #undef CMASK
  #undef FBIAS
  #undef CINIT
  #undef START
  #undef RESC
  #undef ROT
}
constexpr int ATTN_LDS_BYTES=LDS_BYTES;
#undef SBAR
#undef WAIT_BAR
}
#define GAS __attribute__((address_space(1)))
#define LAS __attribute__((address_space(3)))
typedef unsigned short bf16;
typedef unsigned v4u __attribute__((ext_vector_type(4)));
typedef float f32x4 __attribute__((ext_vector_type(4)));
typedef short bf16x8 __attribute__((ext_vector_type(8)));
typedef GAS unsigned gu32;
typedef GAS unsigned long long gu64;
#define RLX_AGENT __ATOMIC_RELAXED, __HIP_MEMORY_SCOPE_AGENT
#define LDS_WAIT() asm volatile("s_waitcnt lgkmcnt(0)" ::: "memory")
#define VM_WAIT() asm volatile("s_waitcnt vmcnt(0)" ::: "memory")
__device__ __forceinline__ unsigned long long rt() { return __builtin_amdgcn_s_memrealtime(); }
__device__ __forceinline__ unsigned f2bf(float f) { unsigned u = __builtin_bit_cast(unsigned, f); return (u + 0x7fffu + ((u >> 16) & 1u)) >> 16; }
__device__ __forceinline__ unsigned pk2(float lo, float hi) { return f2bf(lo) | (f2bf(hi) << 16); }

#define XB_TMO      128
#define XB_XCNT(j)  (256  + 64 * (j))
#define XB_XSUB(j)  (1280 + 64 * (j))
#define XB_XGEN(j)  (2304 + 64 * (j))
#define XB_TOP      3328
#define XB_TOPGEN   3392
#define XCD_BAR_WORDS 3456
#define XB_SPIN_CAP (1u << 18)

__device__ __forceinline__ unsigned xb_ld(unsigned* p)              { return __hip_atomic_load(p, __ATOMIC_RELAXED, __HIP_MEMORY_SCOPE_AGENT); }
__device__ __forceinline__ unsigned xb_add(unsigned* p, unsigned v) { return __hip_atomic_fetch_add(p, v, __ATOMIC_RELAXED, __HIP_MEMORY_SCOPE_AGENT); }
__device__ __forceinline__ unsigned xb_xcc_id() { return (unsigned)__builtin_amdgcn_s_getreg((3 << 11) | 20) & 0xFu; }
#define XB_SPIN(cond, bar) do { unsigned _sp = 0; while (cond) { __builtin_amdgcn_s_sleep(1); \
    if ((++_sp & 255u) == 0u) { if (xb_ld(&(bar)[XB_TMO])) break; if (_sp > XB_SPIN_CAP) { atomicAdd(&(bar)[XB_TMO], 1u); break; } } } } while (0)

struct XcdBarrier {
    unsigned* bar; unsigned x;
    volatile LAS unsigned* st;
};

__device__ __forceinline__ XcdBarrier xcd_barrier_post(unsigned* bar, volatile LAS unsigned* st) {
    XcdBarrier b; b.bar = bar; b.x = xb_xcc_id(); b.st = st;
    if (threadIdx.x == 0) (void)xb_add(&bar[XB_XCNT(b.x)], 1u);
    return b;
}
__device__ __forceinline__ void xcd_barrier_complete(unsigned* bar, unsigned x, unsigned& nloc, unsigned& nx) {
    const unsigned G = gridDim.x * gridDim.y * gridDim.z;
    unsigned sum, cnt, mine, sp = 0u;
    for (;;) {
        sum = 0u; cnt = 0u; mine = 0u;
#pragma unroll
        for (unsigned j = 0; j < 16; ++j) { const unsigned c = xb_ld(&bar[XB_XCNT(j)]); sum += c; cnt += (c > 0u) ? 1u : 0u; mine = (j == x) ? c : mine; }
        if (sum == G) break;
        __builtin_amdgcn_s_sleep(1);
        if ((++sp & 255u) == 0u) { if (xb_ld(&bar[XB_TMO])) break; if (sp > XB_SPIN_CAP) { atomicAdd(&bar[XB_TMO], 1u); break; } }
    }
    nloc = mine > 0u ? mine : 1u; nx = cnt > 0u ? cnt : 1u;
}

__device__ __forceinline__ void xcd_barrier(const XcdBarrier& b) {
    asm volatile("s_waitcnt vmcnt(0)" ::: "memory");
    __syncthreads();
    if (threadIdx.x == 0) {
        unsigned* bar = b.bar;
        __builtin_amdgcn_s_waitcnt(0);
        unsigned nloc = b.st[0], nx = b.st[1];
        if (nloc == 0u) { xcd_barrier_complete(bar, b.x, nloc, nx); b.st[0] = nloc; b.st[1] = nx; }
        const unsigned old = xb_add(&bar[XB_XSUB(b.x)], 1u);
        const unsigned gen = old / nloc;
        if (old + 1u == (gen + 1u) * nloc) {
            __builtin_amdgcn_fence(__ATOMIC_RELEASE, "agent");
            asm volatile("s_waitcnt vmcnt(0)" ::: "memory");
            const unsigned og = xb_add(&bar[XB_TOP], 1u);
            const unsigned tg = og / nx;
            if (og + 1u == (tg + 1u) * nx) xb_add(&bar[XB_TOPGEN], 1u);
            else XB_SPIN(xb_ld(&bar[XB_TOPGEN]) == tg, bar);
            __builtin_amdgcn_fence(__ATOMIC_ACQUIRE, "agent");
            xb_add(&bar[XB_XGEN(b.x)], 1u);
            asm volatile("s_waitcnt vmcnt(0)" ::: "memory");
        } else {
            XB_SPIN(xb_ld(&bar[XB_XGEN(b.x)]) == gen, bar);
            __builtin_amdgcn_fence(__ATOMIC_ACQUIRE, "agent");
            asm volatile("s_waitcnt vmcnt(0)" ::: "memory");
        }
    }
    __syncthreads();
}
constexpr int NWAVES = 8, NTHR = 512;
constexpr int NB = 4, SEQ = 8192, D = 1024, T = NB * SEQ;
constexpr int NMEM = 256, TM = NB * NMEM;
constexpr int LDY = 2816, FF = 2816, NEXP = 8;
constexpr int Y_Q = 0, Y_K = 384, Y_V = 768, Y_R = 1536, Y_MQ = 2304, Y_X = 2560;
constexpr int Z_K = 0, Z_V = 768, Z_Q = 1536;
constexpr int MIX_OFF = 1536;
constexpr float EPS = 1e-6f;
constexpr float LOG2E = 1.4426950408889634f;
constexpr float C2 = 0.125f * LOG2E;
constexpr int MOE_ROWS = T + NEXP * 256;
constexpr int MOE_TILES = MOE_ROWS / 256;

constexpr size_t MiB = 1u << 20;
constexpr size_t WS_CTL = 0, CTL_ZERO_BYTES = 1 * MiB;
constexpr size_t WS_CS = 1 * MiB;
constexpr size_t WS_SIDE = 3 * MiB;
constexpr size_t WS_EID = 5 * MiB;
constexpr size_t WS_GW = WS_EID + 128 * 1024;
constexpr size_t WS_RSTD = WS_GW + 256 * 1024;
constexpr size_t WS_TOK = 6 * MiB;
constexpr size_t WS_GATE = WS_TOK + 512 * 1024;
constexpr size_t WS_TILEE = 7 * MiB;
constexpr size_t WS_DD = 7 * MiB + 64 * 1024;
constexpr size_t WS_MKV = 8 * MiB;
constexpr size_t WS_XM = 10 * MiB;
constexpr size_t WS_W = 16 * MiB;
constexpr size_t WS_WA = WS_W, WS_WB = WS_WA + 5632 * 1024, WS_WMKV = WS_WB + 5632 * 1024, WS_WO0 = WS_WMKV + 2 * MiB, WS_WO1 = WS_WO0 + 2 * MiB;
constexpr size_t WS_WGU0 = WS_WO1 + 2 * MiB, WS_WD0 = WS_WGU0 + 11 * MiB, WS_WGUM = WS_WD0 + 5632 * 1024, WS_WDM = WS_WGUM + 88 * MiB, WS_WEND = WS_WDM + 44 * MiB;
constexpr size_t WS_Y = 184 * MiB;
constexpr size_t WS_X = 371 * MiB;
constexpr size_t WS_DS = WS_X + 64 * MiB;
constexpr size_t WS_END = WS_X + 2 * (size_t)MOE_ROWS * D * 2;
static_assert(WS_WEND <= WS_Y && WS_Y + (size_t)MOE_ROWS * FF * 2 <= WS_X && WS_END <= 512 * MiB && WS_DS + 256ull * 96 * 192 * 4 <= WS_END, "d_ws map");
constexpr int CW_BAR = 4096;
constexpr int CW_CNT = 16384;
constexpr int RING_OFF = 0, RING_BYTES = 143360;
constexpr int LDSCTL_OFF = RING_BYTES, MISC_OFF = LDSCTL_OFF + 320;
constexpr int LDS_BYTES = 147456;
static_assert(MISC_OFF + 128 <= LDS_BYTES, "LDS map");

__device__ __forceinline__ float bf2f(unsigned short v) { return __uint_as_float((unsigned)v << 16); }
__device__ __forceinline__ float wave_sum(float v) {
#pragma unroll
    for (int o = 1; o < 64; o <<= 1) v += __shfl_xor(v, o);
    return v;
}
__device__ __forceinline__ void cvt_item(const float* W, int ldw, int col0, int ncr, bf16* WT, int ldt, int drow, const float* gain, float scale, LAS float* scr, int k0, int n0, int lane) {
    const int n = lane & 31; const bool ok = (n0 + n) < ncr;
#pragma unroll 8
    for (int i = 0; i < 32; ++i) { const int kk = 2 * i + (lane >> 5); float v = 0.f;
        if (ok) { v = W[(size_t)(k0 + kk) * ldw + col0 + n0 + n] * scale; if (gain) v *= gain[k0 + kk]; }
        scr[kk * 33 + n] = v; }
    LDS_WAIT(); asm volatile("" ::: "memory");
    const int c = lane & 7;
#pragma unroll
    for (int j = 0; j < 4; ++j) { const int nn = (lane >> 3) + 8 * j; const LAS float* s = scr + (8 * c) * 33 + nn;
        v4u o; o.x = pk2(s[0 * 33], s[1 * 33]); o.y = pk2(s[2 * 33], s[3 * 33]); o.z = pk2(s[4 * 33], s[5 * 33]); o.w = pk2(s[6 * 33], s[7 * 33]);
        *(GAS v4u*)(WT + (size_t)(drow + nn) * ldt + k0 + 8 * c) = o; }
    LDS_WAIT(); asm volatile("" ::: "memory");
}
__device__ __forceinline__ float rms_row_to_bf16(const float* xrow, bf16* orow, int lane) {
    const GAS f32x4* xr = (const GAS f32x4*)xrow + lane;
    f32x4 v[4]; float s = 0.f;
#pragma unroll
    for (int j = 0; j < 4; ++j) { v[j] = xr[64 * j]; s += (v[j].x * v[j].x + v[j].y * v[j].y) + (v[j].z * v[j].z + v[j].w * v[j].w); }
    const float rstd = 1.0f / sqrtf(wave_sum(s) * (1.f / D) + EPS);
    GAS unsigned long long* o8 = (GAS unsigned long long*)orow + lane;
#pragma unroll
    for (int j = 0; j < 4; ++j) o8[64 * j] = (unsigned long long)pk2(v[j].x * rstd, v[j].y * rstd) | ((unsigned long long)pk2(v[j].z * rstd, v[j].w * rstd) << 32);
    return rstd;
}

struct Args { const float* in[23]; float* out; unsigned char* ws; int ph_lo, ph_hi; };

__device__ __forceinline__ void p_prologue(const Args& A, LAS unsigned char* lds, int gw, int NGW, int wave, int lane) {
    LAS float* scr = (LAS float*)(lds + RING_OFF + wave * 16384);
    unsigned char* ws = A.ws;
    const float* nmix = A.in[2]; const float* nmem = A.in[3]; const float* nffn = A.in[4]; const float* nkv = A.in[5];
    const float* w_in_a = A.in[7]; const float* w_in_b = A.in[11]; const float* w_kv = A.in[12]; const float* w_mkv = A.in[14]; const float* w_out = A.in[15];
    const float* w_g = A.in[16]; const float* w_u = A.in[17]; const float* w_d = A.in[18]; const float* wm_g = A.in[20]; const float* wm_u = A.in[21]; const float* wm_d = A.in[22];
    bf16* WA = (bf16*)(ws + WS_WA); bf16* WB = (bf16*)(ws + WS_WB); bf16* WMKV = (bf16*)(ws + WS_WMKV); bf16* WO0 = (bf16*)(ws + WS_WO0); bf16* WO1 = (bf16*)(ws + WS_WO1);
    bf16* WGU0 = (bf16*)(ws + WS_WGU0); bf16* WD0 = (bf16*)(ws + WS_WD0); bf16* WGUM = (bf16*)(ws + WS_WGUM); bf16* WDM = (bf16*)(ws + WS_WDM);
    constexpr int KB = D / 64;
    constexpr int I_A = KB * (2592 / 32), I_B = KB * (2592 / 32), I_MKV = 2 * KB * 16, I_O = 2 * KB * 32, I_GU = 2 * KB * 88, I_D = 44 * 32;
    constexpr int I_MG = NEXP * KB * 88, I_MD = NEXP * 44 * 32;
    constexpr int NITEMS = I_A + I_B + I_MKV + I_O + I_GU + I_D + 2 * I_MG + I_MD;
    const float qs = 0.10206207261596575f;
    for (int it = gw; it < NITEMS; it += NGW) {
        int r = it;
        if (r < I_A) { const int kb = r / 81, nb = r % 81, n0 = nb * 32, k0 = kb * 64;
            int col0, nloc, ncr = 1 << 30; float sc = 1.f;
            if (n0 < 384) { col0 = 0; nloc = n0; sc = qs; } else if (n0 < 2304) { col0 = 0; nloc = n0; } else if (n0 < 2560) { col0 = 2320; nloc = n0 - 2304; sc = C2; } else { col0 = 2304; nloc = 0; ncr = 16; }
            cvt_item(w_in_a, 2576, col0, ncr, WA, D, n0, nmix, sc, scr, k0, nloc, lane); continue; } r -= I_A;
        if (r < I_B) { const int kb = r / 81, nb = r % 81, n0 = nb * 32, k0 = kb * 64;
            if (n0 < 1536) cvt_item(w_kv, 1548, 0, 1 << 30, WB, D, n0, nkv, 1.f, scr, k0, n0, lane);
            else if (n0 < 2560) cvt_item(w_in_b, 1024, 0, 1 << 30, WB, D, n0, nmix + D, C2, scr, k0, n0 - 1536, lane);
            else cvt_item(w_kv, 1548, 1536, 12, WB, D, 2560, nkv, 1.f, scr, k0, 0, lane);
            continue; } r -= I_B;
        if (r < I_MKV) { const int l = r / (KB * 16), rr = r % (KB * 16), kb = rr / 16, nb = rr % 16;
            cvt_item(w_mkv + (size_t)l * D * 512, 512, 0, 1 << 30, WMKV, D, 512 * l + nb * 32, nmem + l * D, 1.f, scr, kb * 64, nb * 32, lane); continue; } r -= I_MKV;
        if (r < I_O) { const int l = r / (KB * 32), rr = r % (KB * 32), kb = rr / 32, nb = rr % 32;
            cvt_item(w_out + (size_t)l * D * D, D, 0, 1 << 30, l ? WO1 : WO0, D, nb * 32, nullptr, 1.f, scr, kb * 64, nb * 32, lane); continue; } r -= I_O;
        if (r < I_GU) { const int up = r / (KB * 88), rr = r % (KB * 88), kb = rr / 88, nb = rr % 88, n0 = nb * 32;
            cvt_item(up ? w_u : w_g, FF, 0, 1 << 30, WGU0, D, 256 * (n0 >> 7) + 128 * up + (n0 & 127), nffn, 1.f, scr, kb * 64, n0, lane);
            continue; } r -= I_GU;
        if (r < I_D) { const int kb = r / 32, nb = r % 32; cvt_item(w_d, D, 0, 1 << 30, WD0, FF, nb * 32, nullptr, 1.f, scr, kb * 64, nb * 32, lane); continue; } r -= I_D;
        if (r < 2 * I_MG) { const int up = r / I_MG, r2 = r % I_MG, e = r2 / (KB * 88), rr = r2 % (KB * 88), kb = rr / 88, nb = rr % 88, n0 = nb * 32;
            cvt_item((up ? wm_u : wm_g) + (size_t)e * D * FF, FF, 0, 1 << 30, WGUM + (size_t)e * 5632 * D, D, 256 * (n0 >> 7) + 128 * up + (n0 & 127), nffn + D, 1.f, scr, kb * 64, n0, lane); continue; } r -= 2 * I_MG;
        { const int e = r / (44 * 32), rr = r % (44 * 32), kb = rr / 32, nb = rr % 32;
            cvt_item(wm_d + (size_t)e * FF * D, D, 0, 1 << 30, WDM + (size_t)e * D * FF, FF, nb * 32, nullptr, 1.f, scr, kb * 64, nb * 32, lane); }
    }
    { const v4u z = {0u, 0u, 0u, 0u};
      for (int i = gw * 64 + lane; i < 2 * 224 * 128; i += NGW * 64) { const int m = i / (224 * 128), rr = i % (224 * 128); *((GAS v4u*)((m ? WB : WA) + (size_t)2592 * D) + rr) = z; } }
    bf16* XB = (bf16*)(ws + WS_X); bf16* XM = (bf16*)(ws + WS_XM);
    for (int m = gw; m < T; m += NGW) (void)rms_row_to_bf16(A.in[0] + (size_t)m * D, XB + (size_t)m * D, lane);
    for (int m = gw; m < TM; m += NGW) (void)rms_row_to_bf16(A.in[1] + (size_t)m * D, XM + (size_t)m * D, lane);
}

namespace gla {
typedef short bf16x8 __attribute__((ext_vector_type(8)));
constexpr int SQ = 104, S64 = 72;
constexpr int O_QD = 0, O_KD = O_QD + 64 * SQ * 2, O_KLT = O_KD + 64 * SQ * 2, O_VT = O_KLT + 96 * S64 * 2, O_P = O_VT + 192 * S64 * 2, O_ST = O_P + 64 * S64 * 2;
constexpr int O_GLR = O_ST + 192 * SQ * 2, O_W2 = O_GLR + 4096, O_B2 = O_W2 + 6144, O_SEG = O_B2 + 384, O_EBL = O_SEG + 1536, O_BTOT = O_EBL + 384, O_BBASE = O_BTOT + 384, O_END = O_BBASE + 384;
static_assert(O_END <= RING_BYTES, "gla LDS");
#define MFMA16(a, b, c) __builtin_amdgcn_mfma_f32_16x16x32_bf16((a), (b), (c), 0, 0, 0)
#define FRAG(off) (*(const LAS bf16x8*)(lds + (off)))
__device__ __forceinline__ void pass1(LAS unsigned char* lds, bf16* Y, const float* glrf, const float* w2, const float* b2, float* DS, float* DD, int unit) {
    const int tid = threadIdx.x, lane = tid & 63, w = __builtin_amdgcn_readfirstlane(tid >> 6), l15 = lane & 15, quad = lane >> 4;
    const int bh = unit >> 4, g = unit & 15, b = bh >> 2, h = bh & 3;
    const size_t row0 = (size_t)b * SEQ + (size_t)g * 512;
    LAS bf16* QD = (LAS bf16*)(lds + O_QD); LAS bf16* KD = (LAS bf16*)(lds + O_KD); LAS bf16* KLT = (LAS bf16*)(lds + O_KLT); LAS bf16* VT = (LAS bf16*)(lds + O_VT);
    LAS bf16* P = (LAS bf16*)(lds + O_P); LAS bf16* ST = (LAS bf16*)(lds + O_ST);
    LAS float* GLR = (LAS float*)(lds + O_GLR); LAS float* W2 = (LAS float*)(lds + O_W2); LAS float* B2 = (LAS float*)(lds + O_B2); LAS float* SEG = (LAS float*)(lds + O_SEG);
    LAS float* EBL = (LAS float*)(lds + O_EBL); LAS float* BTOT = (LAS float*)(lds + O_BTOT); LAS float* BBASE = (LAS float*)(lds + O_BBASE);
    for (int i = tid; i < 16 * 96; i += NTHR) W2[i] = w2[(i / 96) * 384 + h * 96 + (i % 96)];
    if (tid < 96) { B2[tid] = b2[h * 96 + tid]; BBASE[tid] = 0.f; }
    for (int i = tid; i < 192 * SQ * 2 / 16; i += NTHR) ((LAS v4u*)ST)[i] = (v4u){0u, 0u, 0u, 0u};
    f32x4 sacc[9];
#pragma unroll
    for (int i = 0; i < 9; ++i) sacc[i] = (f32x4){0.f, 0.f, 0.f, 0.f};
    __syncthreads();
#pragma unroll 1
    for (int n = 0; n < 8; ++n) {
        const size_t r0 = row0 + (size_t)n * 64;
        if (tid < 256) *(LAS f32x4*)(GLR + tid * 4) = *(const f32x4*)(glrf + r0 * 16 + tid * 4);
        for (int i = tid; i < 64 * 24; i += NTHR) { const int t = i / 24, c8 = i % 24; const v4u v = *(const v4u*)(Y + (r0 + t) * LDY + Y_V + h * 192 + c8 * 8);
            LAS bf16* d = VT + (c8 * 8) * S64 + t;
            d[0 * S64] = (bf16)(v.x & 0xffffu); d[1 * S64] = (bf16)(v.x >> 16); d[2 * S64] = (bf16)(v.y & 0xffffu); d[3 * S64] = (bf16)(v.y >> 16);
            d[4 * S64] = (bf16)(v.z & 0xffffu); d[5 * S64] = (bf16)(v.z >> 16); d[6 * S64] = (bf16)(v.w & 0xffffu); d[7 * S64] = (bf16)(v.w >> 16); }
        __syncthreads();
        float la[16]; const int seg = tid / 96, kc = tid % 96;
        if (tid < 384) { float run = 0.f;
#pragma unroll
            for (int i = 0; i < 16; ++i) { const int t = seg * 16 + i; float z = B2[kc];
#pragma unroll
                for (int j = 0; j < 16; ++j) z += GLR[t * 16 + j] * W2[j * 96 + kc];
                const float ls = fminf(z, 0.f) - 0.6931471805599453f * __builtin_amdgcn_logf(1.0f + __builtin_amdgcn_exp2f(-fabsf(z) * LOG2E));
                run += ls * 0.0625f; la[i] = run; }
            SEG[seg * 96 + kc] = run; }
        __syncthreads();
        if (tid < 384) {
            const float s0 = SEG[kc], s1 = SEG[96 + kc], s2 = SEG[192 + kc], s3 = SEG[288 + kc];
            const float pre = (seg > 0 ? s0 : 0.f) + (seg > 1 ? s1 : 0.f) + (seg > 2 ? s2 : 0.f), tot = (s0 + s1) + (s2 + s3), base = BBASE[kc];
            unsigned klp[8];
#pragma unroll
            for (int i = 0; i < 16; ++i) { const int t = seg * 16 + i; const float bt = la[i] + pre;
                bf16* yq = Y + (r0 + t) * LDY + Y_Q + h * 96 + kc;
                const float qv = bf2f(*yq), kv = bf2f(yq[Y_K - Y_Q]);
                QD[t * SQ + kc] = (bf16)f2bf(qv * __expf(bt)); KD[t * SQ + kc] = (bf16)f2bf(kv * __expf(-bt));
                *yq = (bf16)f2bf(qv * __expf(base + bt));
                const unsigned kl = f2bf(kv * __expf(tot - bt));
                if (i & 1) klp[i >> 1] |= kl << 16; else klp[i >> 1] = kl; }
            LAS v4u* kd = (LAS v4u*)(KLT + kc * S64 + seg * 16);
            kd[0] = (v4u){klp[0], klp[1], klp[2], klp[3]}; kd[1] = (v4u){klp[4], klp[5], klp[6], klp[7]};
            if (seg == 0) { EBL[kc] = __expf(tot); BTOT[kc] = tot; } }
        __syncthreads();
        { const int ti = w >> 1;
#pragma unroll
          for (int jj = 0; jj < 2; ++jj) { const int tj = 2 * (w & 1) + jj; f32x4 acc = (f32x4){0.f, 0.f, 0.f, 0.f};
            if (tj <= ti) {
#pragma unroll
                for (int ks = 0; ks < 3; ++ks) acc = MFMA16(FRAG(O_QD + ((ti * 16 + l15) * SQ + ks * 32 + quad * 8) * 2), FRAG(O_KD + ((tj * 16 + l15) * SQ + ks * 32 + quad * 8) * 2), acc); }
#pragma unroll
            for (int j = 0; j < 4; ++j) { const int t = ti * 16 + 4 * quad + j, s = tj * 16 + l15; P[t * S64 + s] = (bf16)f2bf(s <= t ? acc[j] : 0.f); } } }
        __syncthreads();
        { const int tr = w & 3, vb0 = (w >> 2) * 6;
          bf16x8 pa[2], qa[3];
#pragma unroll
          for (int ks = 0; ks < 2; ++ks) pa[ks] = FRAG(O_P + ((tr * 16 + l15) * S64 + ks * 32 + quad * 8) * 2);
#pragma unroll
          for (int ks = 0; ks < 3; ++ks) qa[ks] = FRAG(O_QD + ((tr * 16 + l15) * SQ + ks * 32 + quad * 8) * 2);
#pragma unroll
          for (int i = 0; i < 6; ++i) { const int vb = vb0 + i; f32x4 acc = (f32x4){0.f, 0.f, 0.f, 0.f};
#pragma unroll
            for (int ks = 0; ks < 2; ++ks) acc = MFMA16(pa[ks], FRAG(O_VT + ((vb * 16 + l15) * S64 + ks * 32 + quad * 8) * 2), acc);
#pragma unroll
            for (int ks = 0; ks < 3; ++ks) acc = MFMA16(qa[ks], FRAG(O_ST + ((vb * 16 + l15) * SQ + ks * 32 + quad * 8) * 2), acc);
            bf16* yo = Y + (r0 + tr * 16 + 4 * quad) * LDY + Y_V + h * 192 + vb * 16 + l15;
#pragma unroll
            for (int j = 0; j < 4; ++j) yo[(size_t)j * LDY] = (bf16)f2bf(acc[j]); } }
        __syncthreads();
#pragma unroll
        for (int i = 0; i < 9; ++i) { const int idx = w * 9 + i, kb = idx / 12, vb = idx % 12;
            const f32x4 dec = *(const LAS f32x4*)(EBL + kb * 16 + 4 * quad);
            f32x4 acc = sacc[i] * dec;
#pragma unroll
            for (int ks = 0; ks < 2; ++ks) acc = MFMA16(FRAG(O_KLT + ((kb * 16 + l15) * S64 + ks * 32 + quad * 8) * 2), FRAG(O_VT + ((vb * 16 + l15) * S64 + ks * 32 + quad * 8) * 2), acc);
            sacc[i] = acc;
            *(LAS unsigned long long*)(ST + (vb * 16 + l15) * SQ + kb * 16 + 4 * quad) = (unsigned long long)pk2(acc[0], acc[1]) | ((unsigned long long)pk2(acc[2], acc[3]) << 32); }
        if (tid < 96) BBASE[tid] += BTOT[tid];
        __syncthreads();
    }
#pragma unroll
    for (int i = 0; i < 9; ++i) { const int idx = w * 9 + i, kb = idx / 12, vb = idx % 12; float* d = DS + ((size_t)unit * 96 + kb * 16 + 4 * quad) * 192 + vb * 16 + l15;
#pragma unroll
        for (int j = 0; j < 4; ++j) d[j * 192] = sacc[i][j]; }
    if (tid < 96) DD[unit * 96 + tid] = __expf(BBASE[tid]);
    __syncthreads();
}
__device__ __forceinline__ void pass3(LAS unsigned char* lds, bf16* Y, const float* onorm, const float* DS, const float* DD, int unit) {
    const int tid = threadIdx.x, lane = tid & 63, w = __builtin_amdgcn_readfirstlane(tid >> 6), l15 = lane & 15, quad = lane >> 4;
    const int bh = unit >> 4, g = unit & 15, b = bh >> 2, h = bh & 3;
    const size_t row0 = (size_t)b * SEQ + (size_t)g * 512;
    LAS bf16* ST = (LAS bf16*)(lds + O_ST); LAS float* ON = (LAS float*)(lds + O_GLR); LAS float* SS = (LAS float*)(lds + O_W2);
    { float s[36];
#pragma unroll
      for (int i = 0; i < 36; ++i) s[i] = 0.f;
      for (int j = 0; j < g; ++j) { const float* ds = DS + (size_t)(bh * 16 + j) * 96 * 192; const float* dd = DD + (bh * 16 + j) * 96;
#pragma unroll
        for (int i = 0; i < 36; ++i) { const int idx = tid + NTHR * i; s[i] = dd[idx / 192] * s[i] + ds[idx]; } }
#pragma unroll
      for (int i = 0; i < 36; ++i) { const int idx = tid + NTHR * i; ST[(idx % 192) * SQ + idx / 192] = (bf16)f2bf(s[i]); } }
    if (tid < 192) ON[tid] = onorm[tid];
    __syncthreads();
    const int tr = w & 3, vb0 = (w >> 2) * 6;
#pragma unroll 1
    for (int n = 0; n < 8; ++n) {
        const size_t r0 = row0 + (size_t)n * 64;
        bf16x8 qa[3];
#pragma unroll
        for (int ks = 0; ks < 3; ++ks) qa[ks] = *(const bf16x8*)(Y + (r0 + tr * 16 + l15) * LDY + Y_Q + h * 96 + ks * 32 + quad * 8);
        f32x4 acc[6]; float ssq[4] = {0.f, 0.f, 0.f, 0.f};
#pragma unroll
        for (int i = 0; i < 6; ++i) { const int vb = vb0 + i; f32x4 a = (f32x4){0.f, 0.f, 0.f, 0.f};
#pragma unroll
            for (int ks = 0; ks < 3; ++ks) a = MFMA16(qa[ks], FRAG(O_ST + ((vb * 16 + l15) * SQ + ks * 32 + quad * 8) * 2), a);
            const bf16* yo = Y + (r0 + tr * 16 + 4 * quad) * LDY + Y_V + h * 192 + vb * 16 + l15;
#pragma unroll
            for (int j = 0; j < 4; ++j) { a[j] += bf2f(yo[(size_t)j * LDY]); ssq[j] += a[j] * a[j]; }
            acc[i] = a; }
#pragma unroll
        for (int j = 0; j < 4; ++j) { float v = ssq[j]; v += __shfl_xor(v, 1); v += __shfl_xor(v, 2); v += __shfl_xor(v, 4); v += __shfl_xor(v, 8); ssq[j] = v; }
        if (l15 == 0) {
#pragma unroll
            for (int j = 0; j < 4; ++j) SS[(tr * 16 + 4 * quad + j) * 2 + (w >> 2)] = ssq[j]; }
        __syncthreads();
        float rs[4];
#pragma unroll
        for (int j = 0; j < 4; ++j) { const int t = tr * 16 + 4 * quad + j; rs[j] = 1.0f / sqrtf((SS[t * 2] + SS[t * 2 + 1]) * (1.f / 192.f) + EPS); }
#pragma unroll
        for (int i = 0; i < 6; ++i) { const int dv = (vb0 + i) * 16 + l15; const float gn = ON[dv];
            bf16* yr = Y + (r0 + tr * 16 + 4 * quad) * LDY + Y_R + h * 192 + dv;
#pragma unroll
            for (int j = 0; j < 4; ++j) { const float rv = bf2f(yr[(size_t)j * LDY]); yr[(size_t)j * LDY] = (bf16)f2bf(acc[i][j] * rs[j] * gn * pg8::silu_f(rv)); } }
        __syncthreads();
    }
}
#undef MFMA16
#undef FRAG
}

constexpr int N_PHASES = 19;
__global__ void __launch_bounds__(NTHR, 2) fwd_kernel(Args args) {
    extern __shared__ __attribute__((aligned(16))) unsigned char lds_raw[];
    LAS unsigned char* lds = (LAS unsigned char*)lds_raw;
    volatile LAS unsigned* MISC = (volatile LAS unsigned*)(lds + MISC_OFF);
    const int wave = __builtin_amdgcn_readfirstlane((int)threadIdx.x >> 6);
#define PH_TID() int tid = threadIdx.x; asm volatile("" : "+v"(tid)); const int lane = tid & 63; (void)lane
    const int G = gridDim.x; const int bx = blockIdx.x; const int vcu = (G % 8 == 0) ? (bx % 8) * (G / 8) + bx / 8 : bx;
    const int gw = vcu * NWAVES + wave, NGW = G * NWAVES;
    unsigned char* ws = args.ws;
    gu32* ctl = (gu32*)(ws + WS_CTL);
    { PH_TID(); for (int u = tid; u < (LDS_BYTES - LDSCTL_OFF) / 4; u += NTHR) ((LAS unsigned*)(lds + LDSCTL_OFF))[u] = 0u; }
    __syncthreads();
    const bool multi = (args.ph_hi - args.ph_lo) > 1;
    XcdBarrier bar; bar.bar = (unsigned*)(ctl + CW_BAR); bar.x = 0; bar.st = nullptr;
    if (multi) bar = xcd_barrier_post((unsigned*)(ctl + CW_BAR), MISC + 8);
    const int lo = args.ph_lo, hi = args.ph_hi;
#define IN(k) (lo <= (k) && (k) < hi)
#define SEAM(k) do { if (IN(k) && IN((k) + 1)) xcd_barrier(bar); } while (0)

    bf16* Y = (bf16*)(ws + WS_Y); bf16* XB = (bf16*)(ws + WS_X); bf16* HB = (bf16*)(ws + WS_Y);
    float* SIDE = (float*)(ws + WS_SIDE); float* CS = (float*)(ws + WS_CS);
    bf16* MKV = (bf16*)(ws + WS_MKV);
    float* DSb = (float*)(ws + WS_DS); float* DDb = (float*)(ws + WS_DD);
    int* EID = (int*)(ws + WS_EID); float* GWT = (float*)(ws + WS_GW); float* RSTD = (float*)(ws + WS_RSTD);
    int* TOK = (int*)(ws + WS_TOK); float* GATE = (float*)(ws + WS_GATE); int* TILEE = (int*)(ws + WS_TILEE);
    float* OUT = args.out;

    if (IN(0)) { PH_TID(); p_prologue(args, lds, gw, NGW, wave, lane); }
    SEAM(0);
    if (IN(1)) {
        { pg8::Gemm g{XB, (const bf16*)(ws + WS_WA), T, LDY, D, D, D, 0}; pg8::StaticOrder S; S.init(T, LDY, G, bx);
          pg8::EpiBf16 E{Y, LDY, SIDE, 10};
          pg8::gemm_phase<pg8::EpiBf16, pg8::StaticOrder, true, true>(lds + RING_OFF, g, S, E); }
        { pg8::Gemm g{(const bf16*)(ws + WS_XM), (const bf16*)(ws + WS_WMKV), TM, 1024, D, D, D, 0}; pg8::StaticOrder S; S.init(TM, 1024, G, (bx + G - (G / 2)) % G);
          pg8::EpiBf16 E{MKV, 1024, nullptr, -1};
          pg8::gemm_phase<pg8::EpiBf16, pg8::StaticOrder, true, true>(lds + RING_OFF, g, S, E); }
    }
    SEAM(1);
    if (IN(2)) {
        for (int u = vcu; u < 256; u += G) gla::pass1(lds + RING_OFF, Y, SIDE, args.in[8], args.in[9], DSb, DDb, u);
        for (int u = vcu; u < 512; u += G) { const int qblk = u >> 2, h = u & 3, b = qblk >> 5;
            attn_body::attn_unit<8, false, false, LDY, 1024>((long)qblk * 256, (long)b * NMEM, 4, (const attn_body::bf16*)(Y + Y_MQ + h * 64), (const attn_body::bf16*)(MKV + h * 64), (const attn_body::bf16*)(MKV + 256 + h * 64),
                (attn_body::bf16*)(Y + Y_MQ + h * 64), nullptr, (char*)lds_raw + RING_OFF); }
    }
    SEAM(2);
    if (IN(3)) { for (int u = vcu; u < 256; u += G) gla::pass3(lds + RING_OFF, Y, args.in[10], DSb, DDb, u); }
    SEAM(3);
    if (IN(4)) { pg8::Gemm g{Y + MIX_OFF, (const bf16*)(ws + WS_WO0), T, D, D, LDY, D, 0}; pg8::StaticOrder S; S.init(T, D, G, bx);
        pg8::EpiResF32 E{args.in[0], OUT, D};
        pg8::gemm_phase<pg8::EpiResF32, pg8::StaticOrder, true, true>(lds + RING_OFF, g, S, E); }
    SEAM(4);
    if (IN(5)) { PH_TID(); for (int m = gw; m < T; m += NGW) (void)rms_row_to_bf16(OUT + (size_t)m * D, XB + (size_t)m * D, lane); }
    SEAM(5);
    if (IN(6)) { pg8::Gemm g{XB, (const bf16*)(ws + WS_WGU0), T, 2 * FF, D, D, D, 0}; pg8::StaticOrder S; S.init(T, 2 * FF, G, bx);
        pg8::EpiSwiGLU E{HB, FF};
        pg8::gemm_phase<pg8::EpiSwiGLU, pg8::StaticOrder, true, true>(lds + RING_OFF, g, S, E); }
    SEAM(6);
    if (IN(7)) { pg8::Gemm g{HB, (const bf16*)(ws + WS_WD0), T, D, FF, FF, FF, 0}; pg8::StaticOrder S; S.init(T, D, G, bx);
        pg8::EpiResF32 E{OUT, OUT, D};
        pg8::gemm_phase<pg8::EpiResF32, pg8::StaticOrder, true, true>(lds + RING_OFF, g, S, E); }
    SEAM(7);
    if (IN(8)) { PH_TID(); for (int m = gw; m < T; m += NGW) (void)rms_row_to_bf16(OUT + (size_t)m * D, XB + (size_t)m * D, lane); }
    SEAM(8);
    if (IN(9)) { pg8::Gemm g{XB, (const bf16*)(ws + WS_WB), T, LDY, D, D, D, 0}; pg8::StaticOrder S; S.init(T, LDY, G, bx);
        pg8::EpiBf16 E{Y, LDY, SIDE, 10};
        pg8::gemm_phase<pg8::EpiBf16, pg8::StaticOrder, true, true>(lds + RING_OFF, g, S, E); }
    SEAM(9);
    if (IN(10)) { PH_TID();
        for (int u = vcu; u < 48; u += G) { const int b = u / 12, h = u % 12; LAS float* sc = (LAS float*)(lds + RING_OFF);
            const float bf = args.in[13][h]; float v[16]; float run = 0.f;
#pragma unroll
            for (int i = 0; i < 16; ++i) { const float z = SIDE[((size_t)b * SEQ + tid * 16 + i) * 16 + h] + bf;
                run += fminf(z, 0.f) - 0.6931471805599453f * __builtin_amdgcn_logf(1.0f + __builtin_amdgcn_exp2f(-fabsf(z) * LOG2E)); v[i] = run; }
            sc[tid] = run; __syncthreads();
            if (tid < 64) { float a[8]; float s = 0.f;
#pragma unroll
                for (int i = 0; i < 8; ++i) { s += sc[tid * 8 + i]; a[i] = s; }
                float incl = s;
#pragma unroll
                for (int o = 1; o < 64; o <<= 1) { const float t2 = __shfl_up(incl, o); if (lane >= o) incl += t2; }
                const float excl = incl - s;
#pragma unroll
                for (int i = 0; i < 8; ++i) sc[512 + tid * 8 + i] = excl + a[i]; }
            __syncthreads();
            const float pre = sc[512 + tid] - run;
#pragma unroll
            for (int i = 0; i < 16; ++i) CS[(size_t)u * SEQ + tid * 16 + i] = (v[i] + pre) * LOG2E;
            __syncthreads(); }
        for (int u = vcu; u < 512; u += G) { const int qblk = u >> 2, h = u & 3, b = qblk >> 5;
            attn_body::attn_unit<8, false, false, LDY, 1024>((long)qblk * 256, (long)b * NMEM, 4, (const attn_body::bf16*)(Y + Y_MQ + h * 64), (const attn_body::bf16*)(MKV + 512 + h * 64), (const attn_body::bf16*)(MKV + 768 + h * 64),
                (attn_body::bf16*)(Y + Y_MQ + h * 64), nullptr, (char*)lds_raw + RING_OFF); }
    }
    SEAM(10);
    if (IN(11)) {
        for (int i = 0;; ++i) { const int p = vcu + G * (i >> 1); if (p >= 768) break;
            const int bh = p >> 4, s = p & 15, qb = (i & 1) ? 31 - s : s, b = bh / 12, h = bh % 12;
            attn_body::attn_unit<8, true, true, LDY, LDY>((long)b * SEQ + qb * 256, (long)b * SEQ, 4 * qb + 4, (const attn_body::bf16*)(Y + Z_Q + h * 64), (const attn_body::bf16*)(Y + Z_K + h * 64), (const attn_body::bf16*)(Y + Z_V + h * 64),
                (attn_body::bf16*)(Y + Z_Q + h * 64), CS + (size_t)bh * SEQ, (char*)lds_raw + RING_OFF); }
    }
    SEAM(11);
    if (IN(12)) { pg8::Gemm g{Y + MIX_OFF, (const bf16*)(ws + WS_WO1), T, D, D, LDY, D, 0}; pg8::StaticOrder S; S.init(T, D, G, bx);
        pg8::EpiResF32 E{OUT, OUT, D};
        pg8::gemm_phase<pg8::EpiResF32, pg8::StaticOrder, true, true>(lds + RING_OFF, g, S, E); }
    SEAM(12);
    if (IN(13)) { PH_TID();
        LAS unsigned* lc = (LAS unsigned*)(lds + RING_OFF);
        if (tid < 16) lc[tid] = 0u;
        __syncthreads();
        const float* wr = args.in[19]; const float* gf = args.in[4] + D;
        for (int m = gw; m < T; m += NGW) {
            const GAS f32x4* xr = (const GAS f32x4*)(OUT + (size_t)m * D) + lane;
            float s = 0.f; float lg[8];
#pragma unroll
            for (int e = 0; e < 8; ++e) lg[e] = 0.f;
#pragma unroll
            for (int j = 0; j < 4; ++j) { const f32x4 v = xr[64 * j]; s += (v.x * v.x + v.y * v.y) + (v.z * v.z + v.w * v.w);
                const int k0 = 4 * lane + 256 * j; const f32x4 gg = *(const f32x4*)(gf + k0);
#pragma unroll
                for (int c = 0; c < 4; ++c) { const float xv = v[c] * gg[c]; const f32x4 w0 = *(const f32x4*)(wr + (size_t)(k0 + c) * 8), w1 = *(const f32x4*)(wr + (size_t)(k0 + c) * 8 + 4);
                    lg[0] += xv * w0.x; lg[1] += xv * w0.y; lg[2] += xv * w0.z; lg[3] += xv * w0.w; lg[4] += xv * w1.x; lg[5] += xv * w1.y; lg[6] += xv * w1.z; lg[7] += xv * w1.w; } }
            const float rstd = 1.0f / sqrtf(wave_sum(s) * (1.f / D) + EPS);
#pragma unroll
            for (int e = 0; e < 8; ++e) lg[e] = wave_sum(lg[e]) * rstd;
            int i1 = 0; float v1 = lg[0];
#pragma unroll
            for (int e = 1; e < 8; ++e) if (lg[e] > v1) { v1 = lg[e]; i1 = e; }
            int i2 = -1; float v2 = -INFINITY;
#pragma unroll
            for (int e = 0; e < 8; ++e) if (e != i1 && lg[e] > v2) { v2 = lg[e]; i2 = e; }
            if (lane == 0) { const float w2g = 1.0f / (1.0f + __expf(v1 - v2)); EID[m] = i1 | (i2 << 8); GWT[2 * m] = 1.0f - w2g; GWT[2 * m + 1] = w2g; RSTD[m] = rstd;
                __hip_atomic_fetch_add(lc + i1, 1u, __ATOMIC_RELAXED, __HIP_MEMORY_SCOPE_WORKGROUP); __hip_atomic_fetch_add(lc + 8 + i2, 1u, __ATOMIC_RELAXED, __HIP_MEMORY_SCOPE_WORKGROUP); }
        }
        __syncthreads();
        if (tid < 16 && lc[tid]) atomicAdd((unsigned*)(ctl + CW_CNT) + tid, lc[tid]);
        __syncthreads();
    }
    SEAM(13);
    if (IN(14)) { PH_TID();
        LAS int* offs = (LAS int*)(lds + RING_OFF);
        if (tid < 16) { const int p = tid >> 3, e = tid & 7; int o = 0;
            for (int q = 0; q < e; ++q) o += (int)((__hip_atomic_load(ctl + CW_CNT + p * 8 + q, RLX_AGENT) + 255u) & ~255u);
            offs[tid] = o; offs[16 + tid] = (int)__hip_atomic_load(ctl + CW_CNT + tid, RLX_AGENT); }
        __syncthreads();
        if (bx == 0) {
            for (int i = tid; i < 2 * 256; i += NTHR) { const int p = i >> 8, tl = i & 255; int e = 7;
                for (int q = 7; q >= 0; --q) if (tl * 256 < offs[p * 8 + q] + ((offs[16 + p * 8 + q] + 255) & ~255)) e = q;
                TILEE[i] = e; }
            if (tid < 2) TILEE[512 + tid] = (offs[tid * 8 + 7] + ((offs[16 + tid * 8 + 7] + 255) & ~255)) >> 8;
            for (int i = tid; i < 16 * 256; i += NTHR) { const int pe = i >> 8, j = i & 255, c = offs[16 + pe], padn = ((c + 255) & ~255) - c;
                if (j < padn) { TOK[(pe >> 3) * MOE_ROWS + offs[pe] + c + j] = -1; GATE[(pe >> 3) * MOE_ROWS + offs[pe] + c + j] = 0.f; } }
        }
        bf16* XS = (bf16*)(ws + WS_X);
        for (int m = gw; m < T; m += NGW) {
            const int eid = EID[m]; const float rstd = RSTD[m];
            int pos0 = 0, pos1 = 0;
            if (lane == 0) { const int e0 = eid & 255, e1 = eid >> 8;
                pos0 = offs[e0] + (int)__hip_atomic_fetch_add(ctl + CW_CNT + 64 + e0, 1u, RLX_AGENT);
                pos1 = offs[8 + e1] + (int)__hip_atomic_fetch_add(ctl + CW_CNT + 64 + 8 + e1, 1u, RLX_AGENT);
                TOK[pos0] = m; TOK[MOE_ROWS + pos1] = m; GATE[pos0] = GWT[2 * m]; GATE[MOE_ROWS + pos1] = GWT[2 * m + 1]; }
            pos0 = __builtin_amdgcn_readfirstlane(pos0); pos1 = __builtin_amdgcn_readfirstlane(pos1);
            const GAS f32x4* xr = (const GAS f32x4*)(OUT + (size_t)m * D) + lane;
            GAS unsigned long long* o0 = (GAS unsigned long long*)(XS + (size_t)pos0 * D) + lane; GAS unsigned long long* o1 = (GAS unsigned long long*)(XS + ((size_t)MOE_ROWS + pos1) * D) + lane;
#pragma unroll
            for (int j = 0; j < 4; ++j) { const f32x4 v = xr[64 * j]; const unsigned long long pk = (unsigned long long)pk2(v.x * rstd, v.y * rstd) | ((unsigned long long)pk2(v.z * rstd, v.w * rstd) << 32); o0[64 * j] = pk; o1[64 * j] = pk; }
        }
        __syncthreads();
    }
    SEAM(14);
    if (IN(15)) { const int nM = __builtin_amdgcn_readfirstlane(TILEE[512]);
        pg8::Gemm g{(const bf16*)(ws + WS_X), (const bf16*)(ws + WS_WGUM), MOE_ROWS, 2 * FF, D, D, D, (size_t)2 * FF * D}; pg8::MoeOrder S; S.init(nM, 2 * FF, G, bx, TILEE);
        pg8::EpiSwiGLU E{HB, FF};
        pg8::gemm_phase<pg8::EpiSwiGLU, pg8::MoeOrder, true, true>(lds + RING_OFF, g, S, E); }
    SEAM(15);
    if (IN(16)) { const int nM = __builtin_amdgcn_readfirstlane(TILEE[512]);
        pg8::Gemm g{HB, (const bf16*)(ws + WS_WDM), MOE_ROWS, D, FF, FF, FF, (size_t)D * FF}; pg8::MoeOrder S; S.init(nM, D, G, bx, TILEE);
        pg8::EpiScatter E{TOK, GATE, OUT, D};
        pg8::gemm_phase<pg8::EpiScatter, pg8::MoeOrder, true, true>(lds + RING_OFF, g, S, E); }
    SEAM(16);
    if (IN(17)) { const int nM = __builtin_amdgcn_readfirstlane(TILEE[513]);
        pg8::Gemm g{(const bf16*)(ws + WS_X) + (size_t)MOE_ROWS * D, (const bf16*)(ws + WS_WGUM), MOE_ROWS, 2 * FF, D, D, D, (size_t)2 * FF * D}; pg8::MoeOrder S; S.init(nM, 2 * FF, G, bx, TILEE + 256);
        pg8::EpiSwiGLU E{HB, FF};
        pg8::gemm_phase<pg8::EpiSwiGLU, pg8::MoeOrder, true, true>(lds + RING_OFF, g, S, E); }
    SEAM(17);
    if (IN(18)) { const int nM = __builtin_amdgcn_readfirstlane(TILEE[513]);
        pg8::Gemm g{HB, (const bf16*)(ws + WS_WDM), MOE_ROWS, D, FF, FF, FF, (size_t)D * FF}; pg8::MoeOrder S; S.init(nM, D, G, bx, TILEE + 256);
        pg8::EpiScatter E{TOK + MOE_ROWS, GATE + MOE_ROWS, OUT, D};
        pg8::gemm_phase<pg8::EpiScatter, pg8::MoeOrder, true, true>(lds + RING_OFF, g, S, E); }
    if (IN(18) && IN(19)) xcd_barrier(bar);
    if (IN(19)) { PH_TID(); const float* gfin = args.in[6];
        for (int m = gw; m < T; m += NGW) { GAS f32x4* xr = (GAS f32x4*)(OUT + (size_t)m * D) + lane; f32x4 v[4]; float s = 0.f;
#pragma unroll
            for (int j = 0; j < 4; ++j) { v[j] = xr[64 * j]; s += (v[j].x * v[j].x + v[j].y * v[j].y) + (v[j].z * v[j].z + v[j].w * v[j].w); }
            const float rstd = 1.0f / sqrtf(wave_sum(s) * (1.f / D) + EPS);
#pragma unroll
            for (int j = 0; j < 4; ++j) { const f32x4 gg = *(const f32x4*)(gfin + 4 * lane + 256 * j); xr[64 * j] = v[j] * rstd * gg; } } }
#undef IN
#undef SEAM
#undef PH_TID
}

#ifndef MK_PER_PHASE
#define MK_PER_PHASE 0
#endif
extern "C" void kernel_launch(void* const* d_in, const int* in_sizes, int n_in, void* d_out, int out_size, void* d_ws, size_t ws_size, hipStream_t stream) {
    static int grid = 0;
    if (grid == 0) {
        if (n_in != 23 || in_sizes[0] != T * D || out_size != T * D || ws_size < WS_END) { fprintf(stderr, "kernel_launch: unexpected shapes (n_in %d, in0 %d, out %d, ws %zu)\n", n_in, n_in > 0 ? in_sizes[0] : -1, out_size, ws_size); grid = -1; return; }
        int dev = 0, cus = 0, per_cu = 0;
        if (hipGetDevice(&dev) != hipSuccess || hipDeviceGetAttribute(&cus, hipDeviceAttributeMultiprocessorCount, dev) != hipSuccess) { grid = -1; return; }
        if (hipFuncSetAttribute((const void*)fwd_kernel, hipFuncAttributeMaxDynamicSharedMemorySize, LDS_BYTES) != hipSuccess) { fprintf(stderr, "kernel_launch: hipFuncSetAttribute failed\n"); grid = -1; return; }
        if (hipOccupancyMaxActiveBlocksPerMultiprocessor(&per_cu, (const void*)fwd_kernel, NTHR, LDS_BYTES) != hipSuccess || per_cu < 1) fprintf(stderr, "kernel_launch: occupancy query says %d\n", per_cu);
        (void)hipGetLastError();
        grid = cus;
    }
    if (grid < 0) return;
    if (hipMemsetAsync((char*)d_ws + WS_CTL, 0, CTL_ZERO_BYTES, stream) != hipSuccess) return;
    Args a{};
    for (int i = 0; i < 23; ++i) a.in[i] = (const float*)d_in[i];
    a.out = (float*)d_out; a.ws = (unsigned char*)d_ws;
#if MK_PER_PHASE
    for (int p = 0; p <= N_PHASES; ++p) { a.ph_lo = p; a.ph_hi = p + 1; hipLaunchKernelGGL(fwd_kernel, dim3(grid), dim3(NTHR), LDS_BYTES, stream, a); }
#else
    a.ph_lo = 0; a.ph_hi = N_PHASES + 1;
    hipLaunchKernelGGL(fwd_kernel, dim3(grid), dim3(NTHR), LDS_BYTES, stream, a);
#endif
}
```

```cpp
#include <hip/hip_runtime.h>
#include <hip/hip_bf16.h>
#include <cstdio>
#include <cstdint>
#include <cmath>
namespace pg8 {
#define PG8_LAS __attribute__((address_space(3)))
typedef unsigned short bf16_t;
typedef short bf16x8 __attribute__((ext_vector_type(8)));
typedef float f32x4 __attribute__((ext_vector_type(4)));
typedef unsigned u32x4 __attribute__((ext_vector_type(4)));
constexpr int BM = 256, BK = 64, HALF = 128, HTB = HALF * BK * 2  , STAGE_BYTES = 8 * HTB, NXCD = 8, WGM = 4;

__host__ __device__ __forceinline__ int lds_byte(int r, int c) { const int st = (r >> 4) * 2 + (c >> 5), rr = r & 15, cc = c & 31, ob = rr * 64 + cc * 2; return st * 1024 + (ob ^ (((ob >> 9) & 1) << 5)); }
__host__ __device__ __forceinline__ void stage_rc(int b, int& R, int& C) { const int st = b / 1024, sb = b % 1024, swz = sb ^ (((sb >> 9) & 1) << 5); R = (st >> 1) * 16 + swz / 64; C = (st & 1) * 32 + (swz % 64) / 2; }
__host__ __device__ __forceinline__ int perm32(int rho) { const int n = rho >> 4, i = rho & 15; return 8 * (i >> 2) + 4 * n + (i & 3); }

struct Unit { int pm, pn, e; };
struct Gemm { const bf16_t* A; const bf16_t* Bt; int M, N, K, lda, ldb; size_t bes; };

struct StaticOrder {
    int nM, nN, nwg, G, c;
    __host__ __device__ void init(int M, int N, int G_, int c_) { nM = M / BM; nN = N / BM; nwg = nM * nN; G = G_; c = c_; }
    __host__ __device__ bool next(int i, Unit& u) const {
        const long L = (long)i * G + c; if (L >= nwg) return false;
        int wgid = (int)L; { const int q = nwg / NXCD, r = nwg % NXCD, xcd = wgid % NXCD, off = wgid / NXCD; wgid = (xcd < r ? xcd * (q + 1) : r * (q + 1) + (xcd - r) * q) + off; }
        const int nig = WGM * nN, gid = wgid / nig, fm = gid * WGM, gsz = (nM - fm) < WGM ? (nM - fm) : WGM;
        u.pm = fm + ((wgid % nig) % gsz); u.pn = (wgid % nig) / gsz; u.e = 0; return true;
    }
    __device__ __forceinline__ void a_ready(const Unit&) const {}
    __device__ __forceinline__ void done(const Unit&) const {}
};

__device__ __forceinline__ unsigned cvt_pk_bf16(float lo, float hi) { unsigned r; asm volatile("v_cvt_pk_bf16_f32 %0, %1, %2" : "=v"(r) : "v"(lo), "v"(hi)); return r; }
typedef float f32x2 __attribute__((ext_vector_type(2)));
__device__ __forceinline__ float rstd16(const float* ss, int row) { const f32x4* p = (const f32x4*)(ss + (size_t)row * 16); const f32x4 a = p[0], b = p[1], c = p[2], d = p[3];
    const float s = (((a[0] + a[1]) + (a[2] + a[3])) + ((b[0] + b[1]) + (b[2] + b[3]))) + (((c[0] + c[1]) + (c[2] + c[3])) + ((d[0] + d[1]) + (d[2] + d[3]))); return 1.0f / sqrtf(s * (1.0f / 1024.0f) + 1e-6f); }
struct EpiBf16 {
    static constexpr bool PERM = true, AFTER_DRAIN = false;
    bf16_t* O; int ldc; float* side; int side_pn; const float* ss; float scl;
    __device__ __forceinline__ void operator()(const f32x4 (&acc)[2][2][4][2], const Unit& u, int wr, int wc, int fr, int fq) const {
        const int row0 = u.pm * BM + wr * 64 + fr; const int col0 = u.pn * BM + wc * 32 + 8 * fq;
#pragma unroll
        for (int ai = 0; ai < 2; ++ai)
#pragma unroll
            for (int m = 0; m < 4; ++m) { bf16_t* rowp = O + (size_t)(row0 + ai * HALF + m * 16) * ldc + col0;
                const float rs = (ss ? rstd16(ss, row0 + ai * HALF + m * 16) : 1.0f) * scl;
#pragma unroll
                for (int bj = 0; bj < 2; ++bj) { const f32x4 v0 = acc[ai][bj][m][0] * rs, v1 = acc[ai][bj][m][1] * rs;
                    u32x4 w; w.x = cvt_pk_bf16(v0[0], v0[1]); w.y = cvt_pk_bf16(v0[2], v0[3]); w.z = cvt_pk_bf16(v1[0], v1[1]); w.w = cvt_pk_bf16(v1[2], v1[3]);
                    *(u32x4*)(rowp + bj * HALF) = w; } }
        if (side != nullptr && u.pn == side_pn && wc == 0 && fq < 2) {
#pragma unroll
            for (int ai = 0; ai < 2; ++ai)
#pragma unroll
                for (int m = 0; m < 4; ++m) { float* sp = side + (size_t)(row0 + ai * HALF + m * 16) * 16 + 8 * fq;
                    const float rs = (ss ? rstd16(ss, row0 + ai * HALF + m * 16) : 1.0f) * scl;
                    *(f32x4*)(sp) = acc[ai][0][m][0] * rs; *(f32x4*)(sp + 4) = acc[ai][0][m][1] * rs; }
        }
    }
};
template <int LDC, bool HAS_XB, size_t XBO, size_t SSO, bool NTBASE = false> struct EpiResF32 {
    static constexpr bool PERM = false, AFTER_DRAIN = false; static constexpr int ldc = LDC;
    const float* base; float* out; unsigned char* wsb;
    __device__ __forceinline__ void operator()(const f32x4 (&acc)[2][2][4][2], const Unit& u, int wr, int wc, int fr, int fq) const {
        asm volatile("" : "+v"(fr), "+v"(fq));
        const int row0 = u.pm * BM + wr * 64 + fr, col0 = u.pn * BM + wc * 32 + 4 * fq;
#pragma unroll
        for (int ai = 0; ai < 2; ++ai) {
            f32x4 bv[4][2][2];
#pragma unroll
            for (int m = 0; m < 4; ++m) { const size_t off = (size_t)(row0 + ai * HALF + m * 16) * ldc + col0;
#pragma unroll
                for (int bj = 0; bj < 2; ++bj)
#pragma unroll
                    for (int n = 0; n < 2; ++n) bv[m][bj][n] = NTBASE ? __builtin_nontemporal_load((const f32x4*)(base + off + bj * HALF + n * 16)) : *(const f32x4*)(base + off + bj * HALF + n * 16); }
#pragma unroll
            for (int m = 0; m < 4; ++m) { const size_t off = (size_t)(row0 + ai * HALF + m * 16) * ldc + col0;
#pragma unroll
                for (int bj = 0; bj < 2; ++bj)
#pragma unroll
                    for (int n = 0; n < 2; ++n) *(f32x4*)(out + off + bj * HALF + n * 16) = bv[m][bj][n] + acc[ai][bj][m][n]; }
            asm volatile("" ::: "memory"); }
    }
};
__device__ __forceinline__ float silu_f(float g) { return g * __builtin_amdgcn_rcpf(1.0f + __builtin_amdgcn_exp2f(-1.4426950408889634f * g)); }
struct EpiSwiGLU {
    static constexpr bool PERM = true, AFTER_DRAIN = false;
    bf16_t* H; int ldh; const float* ss;
    typedef float f32x2 __attribute__((ext_vector_type(2)));
    static __device__ __forceinline__ unsigned two(f32x2 g, f32x2 u) {
        const f32x2 e = g * (-1.4426950408889634f); f32x2 t; t.x = __builtin_amdgcn_exp2f(e.x); t.y = __builtin_amdgcn_exp2f(e.y);
        const f32x2 d = t + 1.0f; f32x2 r; r.x = __builtin_amdgcn_rcpf(d.x); r.y = __builtin_amdgcn_rcpf(d.y);
        const f32x2 o = (g * u) * r; return cvt_pk_bf16(o.x, o.y);
    }
    __device__ __forceinline__ void operator()(const f32x4 (&acc)[2][2][4][2], const Unit& u, int wr, int wc, int fr, int fq) const {
        const int row0 = u.pm * BM + wr * 64 + fr; const int col0 = u.pn * HALF + wc * 32 + 8 * fq;
#pragma unroll
        for (int ai = 0; ai < 2; ++ai)
#pragma unroll
            for (int m = 0; m < 4; ++m) { bf16_t* rowp = H + (size_t)(row0 + ai * HALF + m * 16) * ldh + col0;
                f32x4 g0 = acc[ai][0][m][0], g1 = acc[ai][0][m][1], u0 = acc[ai][1][m][0], u1 = acc[ai][1][m][1];
                if (ss) { const float rs = rstd16(ss, row0 + ai * HALF + m * 16); g0 *= rs; g1 *= rs; u0 *= rs; u1 *= rs; }
                u32x4 w; w.x = two((f32x2){g0[0], g0[1]}, (f32x2){u0[0], u0[1]}); w.y = two((f32x2){g0[2], g0[3]}, (f32x2){u0[2], u0[3]});
                w.z = two((f32x2){g1[0], g1[1]}, (f32x2){u1[0], u1[1]}); w.w = two((f32x2){g1[2], g1[3]}, (f32x2){u1[2], u1[3]});
                *(u32x4*)rowp = w; }
    }
};
struct EpiScatter {
    static constexpr bool PERM = false, AFTER_DRAIN = false;
    const int* tok; const float* gate; float* out; int ldc; float sc;
    __device__ __forceinline__ void operator()(const f32x4 (&acc)[2][2][4][2], const Unit& u, int wr, int wc, int fr, int fq) const {
        const int row0 = u.pm * BM + wr * 64 + fr, col0 = u.pn * BM + wc * 32 + 4 * fq;
#pragma unroll
        for (int ai = 0; ai < 2; ++ai)
#pragma unroll
            for (int m = 0; m < 4; ++m) { const int r = row0 + ai * HALF + m * 16; const int t = tok[r]; const float gw = gate[r] * sc;
                if (t >= 0) { const size_t off = (size_t)t * ldc + col0;
#pragma unroll
                    for (int bj = 0; bj < 2; ++bj)
#pragma unroll
                        for (int n = 0; n < 2; ++n) { const f32x4 b = *(const f32x4*)(out + off + bj * HALF + n * 16); *(f32x4*)(out + off + bj * HALF + n * 16) = b + acc[ai][bj][m][n] * gw; } }
                if (m & 1) asm volatile("" ::: "memory"); }
    }
};
typedef int i32x8 __attribute__((ext_vector_type(8))); typedef int i32x4 __attribute__((ext_vector_type(4)));
__device__ __forceinline__ i32x8 cat8(bf16x8 a, bf16x8 b) { return __builtin_shufflevector(__builtin_bit_cast(i32x4, a), __builtin_bit_cast(i32x4, b), 0, 1, 2, 3, 4, 5, 6, 7); }
__device__ __forceinline__ void mfma8(f32x4& acc, const i32x8& a, const i32x8& b, int sa, int sb) { asm volatile("v_mfma_scale_f32_16x16x128_f8f6f4 %0, %1, %2, %0, %3, %4 op_sel_hi:[0,0,0]" : "+v"(acc) : "v"(a), "v"(b), "v"(sa), "v"(sb)); }
__device__ __forceinline__ float clamp8(float v) { return __builtin_fminf(__builtin_fmaxf(v, -448.f), 448.f); }
__device__ __forceinline__ unsigned pack_fp8x4(float a, float b, float c, float d) { int p = __builtin_amdgcn_cvt_pk_fp8_f32(clamp8(a), clamp8(b), 0, false); return (unsigned)__builtin_amdgcn_cvt_pk_fp8_f32(clamp8(c), clamp8(d), p, true); }
struct EpiSwiGLU8 {
    static constexpr bool PERM = true, AFTER_DRAIN = false;
    unsigned char* H; int ldh; float hs;
    typedef float f32x2 __attribute__((ext_vector_type(2)));
    template <bool HI> static __device__ __forceinline__ unsigned two(f32x2 g, f32x2 u, float hs_, unsigned old) {
        const f32x2 e = g * (-1.4426950408889634f); f32x2 t; t.x = __builtin_amdgcn_exp2f(e.x); t.y = __builtin_amdgcn_exp2f(e.y);
        const f32x2 d = t + 1.0f; f32x2 r; r.x = __builtin_amdgcn_rcpf(d.x); r.y = __builtin_amdgcn_rcpf(d.y);
        const f32x2 o = ((g * u) * r) * hs_;
        return (unsigned)__builtin_amdgcn_cvt_pk_fp8_f32(__builtin_amdgcn_fmed3f(o.x, -448.f, 448.f), __builtin_amdgcn_fmed3f(o.y, -448.f, 448.f), (int)old, HI);
    }
    __device__ __forceinline__ void operator()(const f32x4 (&acc)[2][2][4][2], const Unit& u, int wr, int wc, int fr, int fq) const {
        const int row0 = u.pm * BM + wr * 64 + fr; const int col0 = u.pn * HALF + wc * 32 + 8 * fq;
#pragma unroll
        for (int ai = 0; ai < 2; ++ai)
#pragma unroll
            for (int m = 0; m < 4; ++m) { unsigned char* rowp = H + (size_t)(row0 + ai * HALF + m * 16) * ldh + col0;
                const f32x4 g0 = acc[ai][0][m][0], g1 = acc[ai][0][m][1], u0 = acc[ai][1][m][0], u1 = acc[ai][1][m][1];
                typedef unsigned u32x2 __attribute__((ext_vector_type(2))); u32x2 w;
                w.x = two<false>((f32x2){g0[0], g0[1]}, (f32x2){u0[0], u0[1]}, hs, 0u); w.x = two<true>((f32x2){g0[2], g0[3]}, (f32x2){u0[2], u0[3]}, hs, w.x);
                w.y = two<false>((f32x2){g1[0], g1[1]}, (f32x2){u1[0], u1[1]}, hs, 0u); w.y = two<true>((f32x2){g1[2], g1[3]}, (f32x2){u1[2], u1[3]}, hs, w.y);
                *(u32x2*)rowp = w; }
    }
};
struct EpiGateBf16 {
    static constexpr bool PERM = true, AFTER_DRAIN = false;
    bf16_t* O; int ldc; const float* gate; float sc;
    __device__ __forceinline__ void operator()(const f32x4 (&acc)[2][2][4][2], const Unit& u, int wr, int wc, int fr, int fq) const {
        const int row0 = u.pm * BM + wr * 64 + fr; const int col0 = u.pn * BM + wc * 32 + 8 * fq;
#pragma unroll
        for (int ai = 0; ai < 2; ++ai)
#pragma unroll
            for (int m = 0; m < 4; ++m) { const int r = row0 + ai * HALF + m * 16; const float gw = gate[r] * sc; bf16_t* rowp = O + (size_t)r * ldc + col0;
#pragma unroll
                for (int bj = 0; bj < 2; ++bj) { const f32x4 v0 = acc[ai][bj][m][0] * gw, v1 = acc[ai][bj][m][1] * gw;
                    u32x4 w; w.x = cvt_pk_bf16(v0[0], v0[1]); w.y = cvt_pk_bf16(v0[2], v0[3]); w.z = cvt_pk_bf16(v1[0], v1[1]); w.w = cvt_pk_bf16(v1[2], v1[3]);
                    *(u32x4*)(rowp + bj * HALF) = w; } }
    }
};
struct MoeOrder {
    StaticOrder so; const PG8_LAS int* tile_e;
    __device__ void init(int nM, int N, int G_, int c_, const PG8_LAS int* te) { so.nM = nM; so.nN = N / BM; so.nwg = nM * so.nN; so.G = G_; so.c = c_; tile_e = te; }
    __device__ bool next(int i, Unit& u) const { if (!so.next(i, u)) return false; u.e = __builtin_amdgcn_readfirstlane(tile_e[u.pm]); return true; }
    __device__ __forceinline__ void a_ready(const Unit&) const {}
    __device__ __forceinline__ void done(const Unit&) const {}
};
template <class Epi, class Sched, bool ALIGN_EPI = false, bool SP2 = false, bool F8 = false, int F8SHIFT = 0>
__device__ __forceinline__ void gemm_phase(PG8_LAS unsigned char* lds, const Gemm g, const Sched& S, const Epi& E) {
    const int tid = threadIdx.x, wid = __builtin_amdgcn_readfirstlane(tid >> 6), lane = tid & 63, wr = wid >> 2, wc = wid & 3, fr = lane & 15, fq = lane >> 4;
    const int K = g.K, nt = K / BK;
    unsigned voffA[2], voffB[2];
#pragma unroll
    for (int i = 0; i < 2; ++i) { int R, C; stage_rc(tid * 16 + i * 8192, R, C); const int Rb = Epi::PERM ? ((R & ~31) + perm32(R & 31)) : R;
        voffA[i] = (unsigned)(R * g.lda + C) * 2u; voffB[i] = (unsigned)(Rb * g.ldb + C) * 2u; }
    const size_t kstep = (size_t)(BK * 2);
    const size_t hstepA = (size_t)HALF * g.lda * 2, hstepB = (size_t)HALF * g.ldb * 2;
    const size_t tstepA = 2 * hstepA, tstepB = 2 * hstepB, estepB = g.bes * 2;
    const unsigned ldsw = (unsigned)wid * 1024u;
    const int aoff = lds_byte(wr * 64 + fr, fq * 8), boff = lds_byte(wc * 32 + fr, fq * 8);
#define PG8_SA(b, h) (((b) * 2 + (h)) * HTB)
#define PG8_SB(b, h) ((4 + (b) * 2 + (h)) * HTB)
#define PG8_STAGE(bufoff, gbase, voff) do { _Pragma("unroll") for (int _i = 0; _i < 2; ++_i) \
        __builtin_amdgcn_global_load_lds((const unsigned*)((const char*)(gbase) + (voff)[_i]), (PG8_LAS unsigned*)(lds + (bufoff) + ldsw + _i * 8192), 16, 0, 0); } while (0)
#define PG8_LDA(dst, b, h) do { _Pragma("unroll") for (int m = 0; m < 4; ++m) { if constexpr (F8) dst##8[m] = cat8(*(const PG8_LAS bf16x8*)(lds + PG8_SA(b, h) + aoff + m * 2048), *(const PG8_LAS bf16x8*)(lds + PG8_SA(b, h) + aoff + m * 2048 + 1024)); \
        else { _Pragma("unroll") for (int k = 0; k < 2; ++k) dst[m][k] = *(const PG8_LAS bf16x8*)(lds + PG8_SA(b, h) + aoff + m * 2048 + k * 1024); } } } while (0)
#define PG8_LDB(dst, b, h) do { _Pragma("unroll") for (int n = 0; n < 2; ++n) { if constexpr (F8) dst##8[n] = cat8(*(const PG8_LAS bf16x8*)(lds + PG8_SB(b, h) + boff + n * 2048), *(const PG8_LAS bf16x8*)(lds + PG8_SB(b, h) + boff + n * 2048 + 1024)); \
        else { _Pragma("unroll") for (int k = 0; k < 2; ++k) dst[n][k] = *(const PG8_LAS bf16x8*)(lds + PG8_SB(b, h) + boff + n * 2048 + k * 1024); } } } while (0)
#define PG8_MMA(ai, bj, At, Bt) do { __builtin_amdgcn_s_setprio(1); _Pragma("unroll") for (int m = 0; m < 4; ++m) _Pragma("unroll") for (int n = 0; n < 2; ++n) { \
        if constexpr (F8) mfma8(acc[ai][bj][m][n], Bt##8[n], At##8[m], one8, scl8); \
        else { _Pragma("unroll") for (int k = 0; k < 2; ++k) acc[ai][bj][m][n] = __builtin_amdgcn_mfma_f32_16x16x32_bf16(Bt[n][k], At[m][k], acc[ai][bj][m][n], 0, 0, 0); } } __builtin_amdgcn_s_setprio(0); } while (0)
#define PG8_WAIT_V(n) asm volatile("s_waitcnt vmcnt(" #n ")" ::: "memory")
#define PG8_WAIT_L(n) asm volatile("s_waitcnt lgkmcnt(" #n ")" ::: "memory")
#define PG8_BAR __builtin_amdgcn_s_barrier()
#define PG8_SCHED __builtin_amdgcn_sched_barrier(0)
    Unit cur, nxt; int ui = 0;
    if (!S.next(0, cur)) return;
    f32x4 acc[2][2][4][2];
#pragma unroll
    for (int a = 0; a < 2; ++a)
#pragma unroll
        for (int b = 0; b < 2; ++b)
#pragma unroll
            for (int m = 0; m < 4; ++m)
#pragma unroll
                for (int n = 0; n < 2; ++n) acc[a][b][m][n] = (f32x4){0.f, 0.f, 0.f, 0.f};
    bf16x8 At[4][2], B0[2][2], B1[2][2];
    int one8 = 0x7F7F7F7F, scl8 = 0x01010101 * (127 - F8SHIFT); asm volatile("" : "+v"(one8), "+v"(scl8));
    i32x8 At8[4], B08[2], B18[2];
    const char* cA = (const char*)g.A + (size_t)cur.pm * tstepA; const char* cB = (const char*)g.Bt + (size_t)cur.e * estepB + (size_t)cur.pn * tstepB;
    S.a_ready(cur);
    if constexpr (SP2) {
        PG8_STAGE(PG8_SB(0, 0), cB, voffB); PG8_STAGE(PG8_SB(0, 1), cB + hstepB, voffB); PG8_STAGE(PG8_SA(0, 0), cA, voffA); PG8_STAGE(PG8_SA(0, 1), cA + hstepA, voffA);
        if (wr == 1) PG8_BAR;
        PG8_WAIT_V(2); PG8_BAR;
        PG8_STAGE(PG8_SB(1, 0), cB + kstep, voffB); PG8_STAGE(PG8_SA(1, 0), cA + kstep, voffA); PG8_STAGE(PG8_SB(1, 1), cB + hstepB + kstep, voffB);
        PG8_WAIT_V(6); PG8_BAR;
    } else {
        PG8_STAGE(PG8_SB(0, 0), cB, voffB); PG8_STAGE(PG8_SA(0, 0), cA, voffA); PG8_STAGE(PG8_SB(0, 1), cB + hstepB, voffB); PG8_STAGE(PG8_SA(0, 1), cA + hstepA, voffA);
        if (wr == 1) PG8_BAR;
        PG8_WAIT_V(4); PG8_BAR;
        PG8_STAGE(PG8_SB(1, 0), cB + kstep, voffB); PG8_STAGE(PG8_SA(1, 0), cA + kstep, voffA); PG8_STAGE(PG8_SB(1, 1), cB + hstepB + kstep, voffB);
        PG8_WAIT_V(6); PG8_BAR;
    }
    for (;;) {
        const bool has_next = S.next(ui + 1, nxt);
        const char* nA = has_next ? (const char*)g.A + (size_t)nxt.pm * tstepA : cA; const char* nB = has_next ? (const char*)g.Bt + (size_t)nxt.e * estepB + (size_t)nxt.pn * tstepB : cB;
#pragma clang loop unroll(disable)
        for (int t = 0; t < nt; t += 2) {
            const bool last = (t == nt - 2);
            const char* a1 = cA + (size_t)(t + 1) * kstep;
            const char* a2 = last ? nA : cA + (size_t)(t + 2) * kstep; const char* b2 = last ? nB : cB + (size_t)(t + 2) * kstep;
            const char* a3 = a2 + kstep; const char* b3 = b2 + kstep;
            if (last && has_next) S.a_ready(nxt);
            if constexpr (SP2) {
            PG8_LDB(B0, 0, 0); PG8_LDB(B1, 0, 1); PG8_SCHED; PG8_LDA(At, 0, 0); PG8_STAGE(PG8_SA(1, 1), a1 + hstepA, voffA);
            PG8_WAIT_V(8); PG8_WAIT_L(0); PG8_BAR; PG8_MMA(0, 0, At, B0); PG8_MMA(0, 1, At, B1); PG8_BAR; PG8_SCHED;
            PG8_LDA(At, 0, 1); PG8_STAGE(PG8_SB(0, 0), b2, voffB); PG8_STAGE(PG8_SB(0, 1), b2 + hstepB, voffB); PG8_STAGE(PG8_SA(0, 0), a2, voffA);
            PG8_WAIT_V(8); PG8_WAIT_L(0); PG8_BAR; PG8_MMA(1, 0, At, B0); PG8_MMA(1, 1, At, B1); PG8_BAR; PG8_SCHED;
            PG8_LDB(B0, 1, 0); PG8_LDB(B1, 1, 1); PG8_SCHED; PG8_LDA(At, 1, 0); PG8_STAGE(PG8_SA(0, 1), a2 + hstepA, voffA);
            PG8_WAIT_V(8); PG8_WAIT_L(0); PG8_BAR; PG8_MMA(0, 0, At, B0); PG8_MMA(0, 1, At, B1); PG8_BAR; PG8_SCHED;
            PG8_LDA(At, 1, 1); PG8_STAGE(PG8_SB(1, 0), b3, voffB); PG8_STAGE(PG8_SB(1, 1), b3 + hstepB, voffB); PG8_STAGE(PG8_SA(1, 0), a3, voffA);
            PG8_WAIT_V(8); PG8_WAIT_L(0); PG8_BAR; PG8_MMA(1, 0, At, B0); PG8_MMA(1, 1, At, B1); PG8_BAR; PG8_SCHED;
            } else {
            PG8_LDB(B0, 0, 0); PG8_SCHED; PG8_LDA(At, 0, 0); PG8_STAGE(PG8_SA(1, 1), a1 + hstepA, voffA);
            PG8_WAIT_L(8); PG8_BAR; PG8_WAIT_L(0); PG8_MMA(0, 0, At, B0); PG8_BAR; PG8_SCHED;
            PG8_LDB(B1, 0, 1); PG8_STAGE(PG8_SB(0, 0), b2, voffB);
            PG8_BAR; PG8_WAIT_L(0); PG8_MMA(0, 1, At, B1); PG8_BAR;
            PG8_LDA(At, 0, 1); PG8_STAGE(PG8_SA(0, 0), a2, voffA);
            PG8_BAR; PG8_WAIT_L(0); PG8_MMA(1, 0, At, B0); PG8_BAR; PG8_SCHED;
            PG8_STAGE(PG8_SB(0, 1), b2 + hstepB, voffB);
            PG8_WAIT_V(6); PG8_BAR; PG8_MMA(1, 1, At, B1); PG8_BAR;
            PG8_LDB(B0, 1, 0); PG8_SCHED; PG8_LDA(At, 1, 0); PG8_STAGE(PG8_SA(0, 1), a2 + hstepA, voffA);
            PG8_WAIT_L(8); PG8_BAR; PG8_WAIT_L(0); PG8_MMA(0, 0, At, B0); PG8_BAR; PG8_SCHED;
            PG8_LDB(B1, 1, 1); PG8_STAGE(PG8_SB(1, 0), b3, voffB);
            PG8_BAR; PG8_WAIT_L(0); PG8_MMA(0, 1, At, B1); PG8_BAR;
            PG8_LDA(At, 1, 1); PG8_STAGE(PG8_SA(1, 0), a3, voffA);
            PG8_BAR; PG8_WAIT_L(0); PG8_MMA(1, 0, At, B0); PG8_BAR; PG8_SCHED;
            PG8_STAGE(PG8_SB(1, 1), b3 + hstepB, voffB);
            PG8_WAIT_V(6); PG8_BAR; PG8_MMA(1, 1, At, B1); PG8_BAR;
            }
        }
        if constexpr (ALIGN_EPI) { if (wr == 0) PG8_BAR; }
        if constexpr (F8) asm volatile("s_nop 15\n\ts_nop 15" ::: "memory");
        if constexpr (!Epi::AFTER_DRAIN) { E(acc, cur, wr, wc, fr, fq); S.done(cur); }
        if (!has_next) break;
#pragma unroll
        for (int a = 0; a < 2; ++a)
#pragma unroll
            for (int b = 0; b < 2; ++b)
#pragma unroll
                for (int m = 0; m < 4; ++m)
#pragma unroll
                    for (int n = 0; n < 2; ++n) acc[a][b][m][n] = (f32x4){0.f, 0.f, 0.f, 0.f};
        cur = nxt; cA = nA; cB = nB; ++ui;
        if constexpr (ALIGN_EPI) { if (wr == 1) PG8_BAR; }
    }
    PG8_WAIT_V(0);
    if constexpr (!ALIGN_EPI) { if (wr == 0) PG8_BAR; }
    PG8_BAR;
    if constexpr (Epi::AFTER_DRAIN) { E.fused(acc, cur, wr, wc, fr, fq, lds, wid, lane); S.done(cur); }
#undef PG8_SA
#undef PG8_SB
#undef PG8_STAGE
#undef PG8_LDA
#undef PG8_LDB
#undef PG8_MMA
#undef PG8_WAIT_V
#undef PG8_WAIT_L
#undef PG8_BAR
#undef PG8_SCHED
}
}
#include <hip/hip_bf16.h>
#include <cmath>
namespace attn_body {
using bf16=__hip_bfloat16;
using bf16x8=__attribute__((ext_vector_type(8)))short;
using s16x4=__attribute__((ext_vector_type(4)))short;
using f32x16=__attribute__((ext_vector_type(16)))float;
using u32x4=__attribute__((ext_vector_type(4)))unsigned;
constexpr int D=64;
constexpr int NW=8,QBLK=32,QB=QBLK*NW,KVBLK=64;
constexpr int ATTN_UNIT_ROWS=QB;
__device__ __forceinline__ int crow(int r,int hi){return (r&3)+8*(r>>2)+4*hi;}
#define SBAR() __builtin_amdgcn_sched_barrier(0)
__device__ __forceinline__ void cmask(f32x16&p0,f32x16&p1,int jb,int qrel,int hi){
  const float NEG=-INFINITY; int kb=64*jb+4*hi;
  #pragma unroll
  for(int r=0;r<16;++r){int kv=kb+(r&3)+8*(r>>2); if(kv>qrel)p0[r]=NEG; if(kv+32>qrel)p1[r]=NEG;}
}

constexpr int NSLOT=3, SLOTB=8192;
constexpr int LDS_K=0, LDS_V=NSLOT*SLOTB, LDS_WS=2*NSLOT*SLOTB, LDS_OST=LDS_WS+NW*64*4, LDS_BYTES=LDS_OST+NW*4096;
constexpr float C2=0.125f*1.4426950408889634f;
__device__ __forceinline__ void glds16(const void*gsrc,unsigned lds_dst){unsigned keep;
  asm volatile("s_mov_b32 %0, m0\n\ts_mov_b32 m0, %2\n\ts_nop 0\n\tglobal_load_lds_dwordx4 %1, off\n\ts_mov_b32 m0, %0":"=&s"(keep):"v"(gsrc),"s"(lds_dst):"memory");}
__device__ __forceinline__ float max3f(float a,float b,float c){float r;asm("v_max3_f32 %0, %1, %2, %3":"=v"(r):"v"(a),"v"(b),"v"(c));return r;}
__device__ __forceinline__ float max2f(float a,float b){float r;asm("v_max_f32_e32 %0, %1, %2":"=v"(r):"v"(a),"v"(b));return r;}
__device__ __forceinline__ float fadd_s(float a,float b){float r;asm("v_add_f32_e32 %0, %1, %2":"=v"(r):"v"(a),"v"(b));return r;}
__device__ __forceinline__ float fsub_s(float a,float b){float r;asm("v_sub_f32_e32 %0, %1, %2":"=v"(r):"v"(a),"v"(b));return r;}
typedef float f32x2_t __attribute__((ext_vector_type(2))); typedef __bf16 bf16x2_t __attribute__((ext_vector_type(2)));
__device__ __forceinline__ unsigned cvtpk_s(float lo,float hi){f32x2_t v={lo,hi};bf16x2_t b=__builtin_convertvector(v,bf16x2_t);return __builtin_bit_cast(unsigned,b);}
#define WAIT_BAR(N) asm volatile("s_waitcnt vmcnt(" #N ") lgkmcnt(0)\n\ts_barrier":::"memory")

__device__ __forceinline__ void qkt(f32x16&p0,f32x16&p1,const char*Kslot,const bf16x8*qr,const f32x16&negm,int r32,int hi){
  const char*kb=Kslot+hi*1024+r32*16;
  #pragma unroll
  for(int d0=0;d0<4;++d0){
    const bf16x8 b0=*reinterpret_cast<const bf16x8*>(kb+d0*2048);
    const bf16x8 b1=*reinterpret_cast<const bf16x8*>(kb+d0*2048+512);
    if(d0==0){p0=__builtin_amdgcn_mfma_f32_32x32x16_bf16(b0,qr[0],negm,0,0,0);p1=__builtin_amdgcn_mfma_f32_32x32x16_bf16(b1,qr[0],negm,0,0,0);}
    else{p0=__builtin_amdgcn_mfma_f32_32x32x16_bf16(b0,qr[d0],p0,0,0,0);p1=__builtin_amdgcn_mfma_f32_32x32x16_bf16(b1,qr[d0],p1,0,0,0);}}
}
typedef __attribute__((address_space(3))) const char* lds_cptr;
typedef short v4i16_t __attribute__((ext_vector_type(4)));
__device__ __forceinline__ void kload8(bf16x8*kf,lds_cptr kp){
  kf[0]=*(const __attribute__((address_space(3))) bf16x8*)(kp);      kf[1]=*(const __attribute__((address_space(3))) bf16x8*)(kp+512);
  kf[2]=*(const __attribute__((address_space(3))) bf16x8*)(kp+2048); kf[3]=*(const __attribute__((address_space(3))) bf16x8*)(kp+2560);
  kf[4]=*(const __attribute__((address_space(3))) bf16x8*)(kp+4096); kf[5]=*(const __attribute__((address_space(3))) bf16x8*)(kp+4608);
  kf[6]=*(const __attribute__((address_space(3))) bf16x8*)(kp+6144); kf[7]=*(const __attribute__((address_space(3))) bf16x8*)(kp+6656);
}
__device__ __forceinline__ void kload2(bf16x8*kf,lds_cptr kp,int j){ kf[2*j]=*(const __attribute__((address_space(3))) bf16x8*)(kp+j*2048); kf[2*j+1]=*(const __attribute__((address_space(3))) bf16x8*)(kp+j*2048+512); }
__device__ __forceinline__ s16x4 vtr(lds_cptr p){ return __builtin_bit_cast(s16x4,__builtin_amdgcn_ds_read_tr16_b64_v4i16((__attribute__((address_space(3))) v4i16_t*)p)); }
__device__ __forceinline__ float rowmax(const f32x16&p0,const f32x16&p1){
  float a=max3f(p0[0],p0[1],p1[0]),b=max3f(p0[2],p0[3],p1[1]);a=max3f(a,p1[2],p1[3]);
  #pragma unroll
  for(int r=4;r<16;r+=4){a=max3f(a,p0[r],p0[r+1]);b=max3f(b,p0[r+2],p0[r+3]);a=max3f(a,p1[r],p1[r+1]);b=max3f(b,p1[r+2],p1[r+3]);}
  const float m=max2f(a,b);
  auto rr=__builtin_amdgcn_permlane32_swap(__float_as_uint(m),__float_as_uint(m),false,false);
  return max2f(__uint_as_float(rr[0]),__uint_as_float(rr[1]));
}
__device__ __forceinline__ void pv(f32x16*o,int vb,bf16x8 pa0,bf16x8 pa1,bf16x8 pa2,bf16x8 pa3){
  #pragma unroll
  for(int d0=0;d0<2;++d0){s16x4 lo[4],hi[4];
    #pragma unroll
    for(int ks=0;ks<4;++ks){
      asm volatile("ds_read_b64_tr_b16 %0,%1 offset:%c2":"=&v"(lo[ks]):"v"(vb),"i"(d0*4096+ks*1024):"memory");
      asm volatile("ds_read_b64_tr_b16 %0,%1 offset:%c2":"=&v"(hi[ks]):"v"(vb),"i"(d0*4096+ks*1024+512):"memory");}
    asm volatile("s_waitcnt lgkmcnt(0)":::"memory");SBAR();
    #define PK(k) (bf16x8){lo[k][0],lo[k][1],lo[k][2],lo[k][3],hi[k][0],hi[k][1],hi[k][2],hi[k][3]}
    o[d0]=__builtin_amdgcn_mfma_f32_32x32x16_bf16(pa0,PK(0),o[d0],0,0,0);
    o[d0]=__builtin_amdgcn_mfma_f32_32x32x16_bf16(pa1,PK(1),o[d0],0,0,0);
    o[d0]=__builtin_amdgcn_mfma_f32_32x32x16_bf16(pa2,PK(2),o[d0],0,0,0);
    o[d0]=__builtin_amdgcn_mfma_f32_32x32x16_bf16(pa3,PK(3),o[d0],0,0,0);
    #undef PK
  }
}

#ifndef ATTN_STORE16
#define ATTN_STORE16(p,v) (*(u32x4*)(p)=(v))
#endif
template<int THRL,bool CAUSAL,bool FOX,int PQ,int PK> __device__ __forceinline__ void attn_unit(long qrow,long kvrow,int NT,const bf16*Q,const bf16*__restrict__ K,const bf16*__restrict__ V,bf16*O,const float*cs,char*shm){
  const int tid=threadIdx.x,lane=tid&63,r32=lane&31,hi=lane>>5; const int wid=__builtin_amdgcn_readfirstlane(tid>>6);
  const bf16*Qw=Q+(qrow+wid*QBLK)*PQ;
  const bf16*Kh=K+kvrow*PK,*Vh=V+kvrow*PK;
  const unsigned lds0=(unsigned)(uintptr_t)shm;
  float*wsf=(float*)(shm+LDS_WS)+wid*64;
  const bf16*ksrc=Kh+(long)lane*PK+wid*8;
  const bf16*vsrc=Vh+(long)(16*(wid&3)+(lane>>2))*PK+(wid>>2)*32+(lane&3)*8;
  const unsigned kdst=lds0+LDS_K+wid*1024, vdst=lds0+LDS_V+wid*1024;
  #define DMA_K(t,slot) glds16(ksrc+(long)(t)*KVBLK*PK,(unsigned)__builtin_amdgcn_readfirstlane(kdst+(slot)))
  #define DMA_V(t,slot) glds16(vsrc+(long)(t)*KVBLK*PK,(unsigned)__builtin_amdgcn_readfirstlane(vdst+(slot)))
  const int vb0=(int)(lds0+LDS_V)+((lane>>4)&1)*32+(lane&3)*8+(4*hi+((lane&15)>>2))*64;
  const char*Kbase=shm+LDS_K; bf16x8 kf[8];
  const lds_cptr shm3=(lds_cptr)shm; const lds_cptr kp0=shm3+LDS_K+hi*1024+r32*16; const lds_cptr vp0=shm3+LDS_V+((lane>>4)&1)*32+(lane&3)*8+(4*hi+((lane&15)>>2))*64;
  typedef __attribute__((address_space(3))) float lds_f32; typedef float f32x4_t __attribute__((ext_vector_type(4)));
  const __attribute__((address_space(3))) f32x4_t* csl=(const __attribute__((address_space(3))) f32x4_t*)(shm3+LDS_BYTES);
  if(FOX){ __attribute__((address_space(3))) f32x4_t* d=(__attribute__((address_space(3))) f32x4_t*)(shm3+LDS_BYTES); const f32x4_t* s=(const f32x4_t*)cs; for(int i=tid;i<NT*16;i+=NW*64)d[i]=s[i]; }
  #define CINIT(P0,P1,t) do{ if(FOX){ const __attribute__((address_space(3))) f32x4_t* cp_=csl+16*(t)+hi; const float nm_=-mhat; \
    _Pragma("unroll") for(int j_=0;j_<4;++j_){ const f32x4_t a_=cp_[2*j_], b_=cp_[8+2*j_]; \
      P0[4*j_]=nm_-a_[0];P0[4*j_+1]=nm_-a_[1];P0[4*j_+2]=nm_-a_[2];P0[4*j_+3]=nm_-a_[3]; P1[4*j_]=nm_-b_[0];P1[4*j_+1]=nm_-b_[1];P1[4*j_+2]=nm_-b_[2];P1[4*j_+3]=nm_-b_[3]; } } }while(0)
  #define FBIAS(P0,P1,t) do{ if(FOX){ const __attribute__((address_space(3))) f32x4_t* cp_=csl+16*(t)+hi; \
    _Pragma("unroll") for(int j_=0;j_<4;++j_){ const f32x4_t a_=cp_[2*j_], b_=cp_[8+2*j_]; \
      P0[4*j_]-=a_[0];P0[4*j_+1]-=a_[1];P0[4*j_+2]-=a_[2];P0[4*j_+3]-=a_[3]; P1[4*j_]-=b_[0];P1[4*j_+1]-=b_[1];P1[4*j_+2]-=b_[2];P1[4*j_+3]-=b_[3]; } } }while(0)
  DMA_K(0,0);DMA_V(0,0);DMA_K(1,SLOTB);
  bf16x8 qr[4];
  #pragma unroll
  for(int d0=0;d0<4;++d0)qr[d0]=*reinterpret_cast<const bf16x8*>(&Qw[(long)r32*PQ+d0*16+hi*8]);
  float mhat=0.f,l_reg=0.f;f32x16 o[2];o[0]=f32x16{};o[1]=f32x16{};f32x16 negm=f32x16{};asm volatile("":"+v"(negm));
  const int qrel=wid*QBLK+r32;
  #define CMASK(P0,P1,t) do{ if(CAUSAL){int jb_=(t)-(NT-4); if(jb_>=0)cmask(P0,P1,jb_,qrel,hi);} }while(0)
  bool resc=false;
  #define START(P0,P1) do{ const float rm=rowmax(P0,P1); resc=false; \
    { const float dl=rm; mhat=fadd_s(mhat,dl); \
      _Pragma("unroll") for(int r=0;r<16;++r){P0[r]=fsub_s(P0[r],dl);P1[r]=fsub_s(P1[r],dl);} \
      _Pragma("unroll") for(int r=0;r<16;++r)negm[r]=-mhat; asm volatile("":"+v"(negm)); } \
    _Pragma("unroll") for(int r=0;r<16;++r)P0[r]=__builtin_amdgcn_exp2f(P0[r]); }while(0)
  #define RESC() do{ if(resc){ asm volatile("s_waitcnt lgkmcnt(0)":::"memory"); \
      _Pragma("unroll") for(int d_=0;d_<2;++d_) _Pragma("unroll") for(int r=0;r<16;++r)o[d_][r]*=wsf[crow(r,hi)]; } }while(0)
  f32x16 pA0,pA1,pB0,pB1;
  int sl_prev=0,sl_cur=0,sl_next=SLOTB;
  #define ROT() do{sl_prev=sl_cur;sl_cur=sl_next;sl_next=(sl_next==(NSLOT-1)*SLOTB)?0:sl_next+SLOTB;}while(0)
  DMA_K(2,2*SLOTB);
  WAIT_BAR(3);
  qkt(pA0,pA1,Kbase,qr,negm,r32,hi);asm volatile("s_nop 15\n\ts_nop 7":"+v"(pA0),"+v"(pA1));FBIAS(pA0,pA1,0);CMASK(pA0,pA1,0);
  START(pA0,pA1);
  _Pragma("unroll") for(int r=0;r<16;++r)pA1[r]=__builtin_amdgcn_exp2f(pA1[r]);
  WAIT_BAR(0);
  DMA_K(3,0);DMA_V(1,SLOTB);
  ROT();
  kload8(kf,kp0+sl_cur);
  WAIT_BAR(2);
  s16x4 vlo[8],vhi[8]; u32x4 pw0,pw1,pw2,pw3;
  #define PKW(P,B) cvtpk_s(P[B],P[B+1])
  #define PAF(k) __builtin_bit_cast(bf16x8,pw##k)
  #define VFR(i) (bf16x8){vlo[i][0],vlo[i][1],vlo[i][2],vlo[i][3],vhi[i][0],vhi[i][1],vhi[i][2],vhi[i][3]}
  #define PIN(x) asm volatile("":"+v"(x))
  #define MX3(a,b,c) __builtin_fmaxf(__builtin_fmaxf((a),(b)),(c))
  #define GAPA(MF,A0,A1,A2,A3,W0,W1,PW) do{ MF; sacc+=A0; sacc+=A1; sacc+=A2; sacc+=A3; PIN(sacc); W0; W1; PIN(PW); SBAR(); }while(0)
  #define EX(v) __builtin_amdgcn_exp2f(v)
  #define GAPB(MF,X,B) do{ MF; X[B]=EX(X[B]); X[B+1]=EX(X[B+1]); X[B+2]=EX(X[B+2]); X[B+3]=EX(X[B+3]); PIN(X); SBAR(); }while(0)
  #define VRD(i) do{ vlo[i]=vtr(vp_+(((i)>>2)*4096+((i)&3)*1024)); vhi[i]=vtr(vp_+(((i)>>2)*4096+((i)&3)*1024+512)); }while(0)
  #define KRD(G,j) do{ if(G){ kload2(kf,kp0+sl_next,j); SBAR(); } }while(0)
  #define STEP(C0,C1,P0,P1,t,GK,GV,GL) do{ SBAR(); CINIT(C0,C1,t); SBAR(); \
    const lds_cptr vp_=vp0+sl_prev; \
    VRD(0); SBAR(); float sacc=(P0[0]+P0[1]); \
    GAPA(C0=__builtin_amdgcn_mfma_f32_32x32x16_bf16(kf[0],qr[0],(FOX?C0:negm),0,0,0), P0[2],P0[3],P0[4],P0[5],     pw0[0]=PKW(P0,0), pw0[1]=PKW(P0,2), pw0); \
    VRD(4); SBAR(); GAPA(C1=__builtin_amdgcn_mfma_f32_32x32x16_bf16(kf[1],qr[0],(FOX?C1:negm),0,0,0), P0[6],P0[7],P0[8],P0[9],     pw0[2]=PKW(P0,4), pw0[3]=PKW(P0,6), pw0); \
    VRD(1); SBAR(); GAPA(C0=__builtin_amdgcn_mfma_f32_32x32x16_bf16(kf[2],qr[1],C0,0,0,0),   P0[10],P0[11],P0[12],P0[13], pw1[0]=PKW(P0,8), pw1[1]=PKW(P0,10), pw1); \
    VRD(5); SBAR(); GAPA(C1=__builtin_amdgcn_mfma_f32_32x32x16_bf16(kf[3],qr[1],C1,0,0,0),   P0[14],P0[15],P1[0],P1[1],   pw1[2]=PKW(P0,12),pw1[3]=PKW(P0,14), pw1); \
    VRD(2); SBAR(); GAPA(C0=__builtin_amdgcn_mfma_f32_32x32x16_bf16(kf[4],qr[2],C0,0,0,0),   P1[2],P1[3],P1[4],P1[5],     pw2[0]=PKW(P1,0), pw2[1]=PKW(P1,2), pw2); \
    VRD(6); SBAR(); GAPA(C1=__builtin_amdgcn_mfma_f32_32x32x16_bf16(kf[5],qr[2],C1,0,0,0),   P1[6],P1[7],P1[8],P1[9],     pw2[2]=PKW(P1,4), pw2[3]=PKW(P1,6), pw2); \
    VRD(3); SBAR(); GAPA(C0=__builtin_amdgcn_mfma_f32_32x32x16_bf16(kf[6],qr[3],C0,0,0,0),   P1[10],P1[11],P1[12],P1[13], pw3[0]=PKW(P1,8), pw3[1]=PKW(P1,10), pw3); \
    VRD(7); SBAR(); GAPA(C1=__builtin_amdgcn_mfma_f32_32x32x16_bf16(kf[7],qr[3],C1,0,0,0),   P1[14],P1[15],0.f,0.f,       pw3[2]=PKW(P1,12),pw3[3]=PKW(P1,14), pw3); \
    l_reg+=sacc; \
    if(GK){DMA_K((t)+3,sl_cur);} if(GV){DMA_V((t)+1,sl_next);} \
    CMASK(C0,C1,t); \
    { float a=MX3(C0[0],C0[1],C1[0]),b=MX3(C0[2],C0[3],C1[1]); a=MX3(a,C1[2],C1[3]); \
      _Pragma("unroll") for(int r=4;r<16;r+=4){a=MX3(a,C0[r],C0[r+1]);b=MX3(b,C0[r+2],C0[r+3]);a=MX3(a,C1[r],C1[r+1]);b=MX3(b,C1[r+2],C1[r+3]);} \
      float rm=__builtin_fmaxf(a,b); { auto rr=__builtin_amdgcn_permlane32_swap(__float_as_uint(rm),__float_as_uint(rm),false,false); rm=__builtin_fmaxf(__uint_as_float(rr[0]),__uint_as_float(rr[1])); } \
      resc=false; \
      if(__builtin_expect(__any(rm>(float)THRL),0)){ const float dl=__builtin_fmaxf(rm,0.f); mhat+=dl; \
        _Pragma("unroll") for(int r=0;r<16;++r){C0[r]-=dl;C1[r]-=dl;} \
        _Pragma("unroll") for(int r=0;r<16;++r)negm[r]=-mhat; asm volatile("":"+v"(negm)); \
        const float f=__builtin_amdgcn_exp2f(-dl); l_reg*=f; if(hi==0)wsf[r32]=f; resc=true; } } \
    SBAR(); \
    GAPB(o[0]=__builtin_amdgcn_mfma_f32_32x32x16_bf16(PAF(0),VFR(0),o[0],0,0,0), C0,0); \
    GAPB(o[1]=__builtin_amdgcn_mfma_f32_32x32x16_bf16(PAF(0),VFR(4),o[1],0,0,0), C0,4); \
    KRD(GL,0); GAPB(o[0]=__builtin_amdgcn_mfma_f32_32x32x16_bf16(PAF(1),VFR(1),o[0],0,0,0), C0,8); \
    KRD(GL,1); GAPB(o[1]=__builtin_amdgcn_mfma_f32_32x32x16_bf16(PAF(1),VFR(5),o[1],0,0,0), C0,12); \
    KRD(GL,2); GAPB(o[0]=__builtin_amdgcn_mfma_f32_32x32x16_bf16(PAF(2),VFR(2),o[0],0,0,0), C1,0); \
    KRD(GL,3); GAPB(o[1]=__builtin_amdgcn_mfma_f32_32x32x16_bf16(PAF(2),VFR(6),o[1],0,0,0), C1,4); \
    GAPB(o[0]=__builtin_amdgcn_mfma_f32_32x32x16_bf16(PAF(3),VFR(3),o[0],0,0,0), C1,8); \
    GAPB(o[1]=__builtin_amdgcn_mfma_f32_32x32x16_bf16(PAF(3),VFR(7),o[1],0,0,0), C1,12); \
    }while(0)
  int t=1;
  #undef CMASK
  #define CMASK(P0,P1,t) do{}while(0)
  for(;t+5<NT;t+=2){
    STEP(pB0,pB1,pA0,pA1,t,true,true,true);     WAIT_BAR(2); RESC(); ROT();
    STEP(pA0,pA1,pB0,pB1,t+1,true,true,true);   WAIT_BAR(2); RESC(); ROT();
  }
  #undef CMASK
  #define CMASK(P0,P1,t) do{ if(CAUSAL){int jb_=(t)-(NT-4); if(jb_>=0)cmask(P0,P1,jb_,qrel,hi);} }while(0)
  #define ENDW(tt) do{ if((tt)+3<NT){WAIT_BAR(2);} else if((tt)+2<NT){WAIT_BAR(1);} else {WAIT_BAR(0);} }while(0)
  for(;t+1<NT;t+=2){
    STEP(pB0,pB1,pA0,pA1,t,(t+3<NT),(t+1<NT),(t+1<NT));       ENDW(t);   RESC(); ROT();
    STEP(pA0,pA1,pB0,pB1,t+1,(t+4<NT),(t+2<NT),(t+2<NT));     ENDW(t+1); RESC(); ROT();
  }
  STEP(pB0,pB1,pA0,pA1,NT-1,false,false,false); RESC();
  { float sacc=pB0[0]+pB0[1]; _Pragma("unroll") for(int r=2;r<16;++r)sacc+=pB0[r]; _Pragma("unroll") for(int r=0;r<16;++r)sacc+=pB1[r]; l_reg+=sacc;
    pw0=(u32x4){PKW(pB0,0),PKW(pB0,2),PKW(pB0,4),PKW(pB0,6)};pw1=(u32x4){PKW(pB0,8),PKW(pB0,10),PKW(pB0,12),PKW(pB0,14)};pw2=(u32x4){PKW(pB1,0),PKW(pB1,2),PKW(pB1,4),PKW(pB1,6)};pw3=(u32x4){PKW(pB1,8),PKW(pB1,10),PKW(pB1,12),PKW(pB1,14)};
    SBAR(); pv(o,vb0+sl_cur,PAF(0),PAF(1),PAF(2),PAF(3)); }
  #undef PKW
  #undef PAF
  #undef VFR
  #undef PIN
  #undef MX3
  #undef GAPA
  #undef GAPB
  #undef EX
  #undef VRD
  #undef KRD
  #undef STEP
  #undef ENDW
  {auto rr=__builtin_amdgcn_permlane32_swap(__float_as_uint(l_reg),__float_as_uint(l_reg),false,false);l_reg=__uint_as_float(rr[0])+__uint_as_float(rr[1]);}
  if(hi==0)wsf[32+r32]=l_reg;asm volatile("s_waitcnt lgkmcnt(0)":::"memory");
  float rli[16];
  #pragma unroll
  for(int r=0;r<16;++r)rli[r]=__builtin_amdgcn_rcpf(wsf[32+crow(r,hi)]);
  bf16*Ow=O+(qrow+wid*QBLK)*PQ;
  { bf16*stg=(bf16*)(shm+LDS_OST)+wid*2048;
    #pragma unroll
    for(int r=0;r<16;++r){const int orow=crow(r,hi);
      #pragma unroll
      for(int d0=0;d0<2;++d0)stg[orow*64+d0*32+r32]=__float2bfloat16(o[d0][r]*rli[r]);}
    asm volatile("s_waitcnt lgkmcnt(0)":::"memory");
    #pragma unroll
    for(int i=0;i<4;++i){const int row=i*8+(lane>>3),ch=lane&7; const u32x4 v=*(const u32x4*)(stg+row*64+ch*8); ATTN_STORE16(Ow+(long)row*PQ+ch*8,v);} }
  asm volatile("s_waitcnt lgkmcnt(0)\n\ts_barrier":::"memory");
  #undef DMA_K
  #undef DMA_V
  #undef CMASK
  #undef FBIAS
  #undef CINIT
  #undef START
  #undef RESC
  #undef ROT
}
constexpr int ATTN_LDS_BYTES=LDS_BYTES;
#undef SBAR
#undef WAIT_BAR
}
#define GAS __attribute__((address_space(1)))
#define LAS __attribute__((address_space(3)))
typedef unsigned short bf16;
typedef unsigned v4u __attribute__((ext_vector_type(4)));
typedef float f32x4 __attribute__((ext_vector_type(4)));
typedef short bf16x8 __attribute__((ext_vector_type(8)));
typedef GAS unsigned gu32;
typedef GAS unsigned long long gu64;
#define RLX_AGENT __ATOMIC_RELAXED, __HIP_MEMORY_SCOPE_AGENT
#define LDS_WAIT() asm volatile("s_waitcnt lgkmcnt(0)" ::: "memory")
#define VM_WAIT() asm volatile("s_waitcnt vmcnt(0)" ::: "memory")
__device__ __forceinline__ unsigned long long rt() { return __builtin_amdgcn_s_memrealtime(); }
__device__ __forceinline__ unsigned f2bf(float f) { unsigned u = __builtin_bit_cast(unsigned, f); return (u + 0x7fffu + ((u >> 16) & 1u)) >> 16; }
__device__ __forceinline__ unsigned pk2(float lo, float hi) { return f2bf(lo) | (f2bf(hi) << 16); }

#define XB_TMO      128
#define XB_XCNT(j)  (256  + 64 * (j))
#define XB_XSUB(j)  (1280 + 64 * (j))
#define XB_XGEN(j)  (2304 + 64 * (j))
#define XB_TOP      3328
#define XB_TOPGEN   3392
#define XCD_BAR_WORDS 3456
#define XB_SPIN_CAP (1u << 18)

__device__ __forceinline__ unsigned xb_ld(unsigned* p)              { return __hip_atomic_load(p, __ATOMIC_RELAXED, __HIP_MEMORY_SCOPE_AGENT); }
__device__ __forceinline__ unsigned xb_add(unsigned* p, unsigned v) { return __hip_atomic_fetch_add(p, v, __ATOMIC_RELAXED, __HIP_MEMORY_SCOPE_AGENT); }
__device__ __forceinline__ unsigned xb_xcc_id() { return (unsigned)__builtin_amdgcn_s_getreg((3 << 11) | 20) & 0xFu; }
#define XB_SPIN(cond, bar) do { unsigned _sp = 0; while (cond) { __builtin_amdgcn_s_sleep(1); \
    if ((++_sp & 255u) == 0u) { if (xb_ld(&(bar)[XB_TMO])) break; if (_sp > XB_SPIN_CAP) { atomicAdd(&(bar)[XB_TMO], 1u); break; } } } } while (0)

struct XcdBarrier {
    unsigned* bar; unsigned x;
    volatile LAS unsigned* st;
};

__device__ __forceinline__ XcdBarrier xcd_barrier_post(unsigned* bar, volatile LAS unsigned* st) {
    XcdBarrier b; b.bar = bar; b.x = xb_xcc_id(); b.st = st;
    if (threadIdx.x == 0) (void)xb_add(&bar[XB_XCNT(b.x)], 1u);
    return b;
}
__device__ __forceinline__ void xcd_barrier_complete(unsigned* bar, unsigned x, unsigned& nloc, unsigned& nx) {
    const unsigned G = gridDim.x * gridDim.y * gridDim.z;
    unsigned sum, cnt, mine, sp = 0u;
    for (;;) {
        sum = 0u; cnt = 0u; mine = 0u;
#pragma unroll
        for (unsigned j = 0; j < 16; ++j) { const unsigned c = xb_ld(&bar[XB_XCNT(j)]); sum += c; cnt += (c > 0u) ? 1u : 0u; mine = (j == x) ? c : mine; }
        if (sum == G) break;
        __builtin_amdgcn_s_sleep(1);
        if ((++sp & 255u) == 0u) { if (xb_ld(&bar[XB_TMO])) break; if (sp > XB_SPIN_CAP) { atomicAdd(&bar[XB_TMO], 1u); break; } }
    }
    nloc = mine > 0u ? mine : 1u; nx = cnt > 0u ? cnt : 1u;
}

__device__ __forceinline__ void xcd_barrier(const XcdBarrier& b) {
    asm volatile("s_waitcnt vmcnt(0)" ::: "memory");
    __syncthreads();
    if (threadIdx.x == 0) {
        unsigned* bar = b.bar;
        __builtin_amdgcn_s_waitcnt(0);
        unsigned nloc = b.st[0], nx = b.st[1];
        if (nloc == 0u) { xcd_barrier_complete(bar, b.x, nloc, nx); b.st[0] = nloc; b.st[1] = nx; }
        const unsigned old = xb_add(&bar[XB_XSUB(b.x)], 1u);
        const unsigned gen = old / nloc;
        if (old + 1u == (gen + 1u) * nloc) {
            __builtin_amdgcn_fence(__ATOMIC_RELEASE, "agent");
            asm volatile("s_waitcnt vmcnt(0)" ::: "memory");
            const unsigned og = xb_add(&bar[XB_TOP], 1u);
            const unsigned tg = og / nx;
            if (og + 1u == (tg + 1u) * nx) xb_add(&bar[XB_TOPGEN], 1u);
            else XB_SPIN(xb_ld(&bar[XB_TOPGEN]) == tg, bar);
            __builtin_amdgcn_fence(__ATOMIC_ACQUIRE, "agent");
            xb_add(&bar[XB_XGEN(b.x)], 1u);
            asm volatile("s_waitcnt vmcnt(0)" ::: "memory");
        } else {
            XB_SPIN(xb_ld(&bar[XB_XGEN(b.x)]) == gen, bar);
            __builtin_amdgcn_fence(__ATOMIC_ACQUIRE, "agent");
            asm volatile("s_waitcnt vmcnt(0)" ::: "memory");
        }
    }
    __syncthreads();
}
constexpr int NWAVES = 8, NTHR = 512;
constexpr int NB = 4, SEQ = 8192, D = 1024, T = NB * SEQ;
constexpr int NMEM = 256, TM = NB * NMEM;
constexpr int LDY = 2816, FF = 2816, NEXP = 8;
constexpr int Y_Q = 0, Y_K = 384, Y_V = 768, Y_R = 1536, Y_MQ = 2304, Y_X = 2560;
constexpr int Z_K = 0, Z_V = 768, Z_Q = 1536;
constexpr int MIX_OFF = 1536;
constexpr float EPS = 1e-6f;
constexpr float LOG2E = 1.4426950408889634f;
constexpr float C2 = 0.125f * LOG2E;
constexpr int MOE_ROWS = T + NEXP * 256;
constexpr int MOE_TILES = MOE_ROWS / 256;
constexpr float F8_SA = 8.f, F8_SW = 256.f, F8_SH = 4.f;

constexpr size_t MiB = 1u << 20;
constexpr size_t WS_CTL = 0, CTL_ZERO_BYTES = 1 * MiB;
constexpr size_t WS_CS = 1 * MiB;
constexpr size_t WS_SIDE = 3 * MiB;
constexpr size_t WS_EID = 5 * MiB;
constexpr size_t WS_GW = WS_EID + 128 * 1024;
constexpr size_t WS_RSTD = WS_GW + 256 * 1024;
constexpr size_t WS_POS = 5 * MiB + 512 * 1024;
constexpr size_t WS_TOK = 6 * MiB;
constexpr size_t WS_GATE = WS_TOK + 512 * 1024;
constexpr size_t WS_TILEE = 7 * MiB;
constexpr size_t WS_KT = 7 * MiB + 256 * 1024;
constexpr size_t WS_DD = 7 * MiB + 64 * 1024;
constexpr size_t WS_MKV = 8 * MiB;
constexpr size_t WS_XM = 10 * MiB;
constexpr size_t WS_W = 16 * MiB;
constexpr size_t WS_WA = WS_W, WS_WB = WS_WA + 5632 * 1024, WS_WMKV = WS_WB + 5632 * 1024, WS_WO0 = WS_WMKV + 2 * MiB, WS_WO1 = WS_WO0 + 2 * MiB;
constexpr size_t WS_WGU0 = WS_WO1 + 2 * MiB, WS_WD0 = WS_WGU0 + 11 * MiB, WS_WGUM = WS_WD0 + 5632 * 1024, WS_WDM = WS_WGUM + 88 * MiB, WS_WEND = WS_WDM + 44 * MiB;
constexpr size_t WS_Y = 184 * MiB;
constexpr size_t WS_X = 371 * MiB;
constexpr size_t WS_DS = WS_X + 64 * MiB;
constexpr size_t WS_END = WS_X + 2 * (size_t)MOE_ROWS * D * 2;
static_assert(F8_SA * F8_SW == 2048.f && F8_SH * F8_SW == 1024.f, "the F8SHIFT template arguments of the fp8 GEMM phases");
static_assert(WS_WEND <= WS_Y && WS_Y + (size_t)MOE_ROWS * FF * 2 <= WS_X && WS_END <= 512 * MiB && WS_DS + 256ull * 96 * 192 * 4 <= WS_END, "d_ws map");
constexpr int CW_BAR = 4096;
constexpr size_t WS_SS1 = 12 * MiB, WS_SS2 = 14 * MiB;
constexpr int CW_Q = 20480;
constexpr float FOX_SKIP = 48.f;
constexpr int CW_CNT = 16384;
constexpr int RING_OFF = 0, RING_BYTES = 157696;
constexpr int LDSCTL_OFF = RING_BYTES, MISC_OFF = LDSCTL_OFF + 320;
constexpr int LDS_BYTES = 158720;
static_assert(MISC_OFF + 128 <= LDS_BYTES, "LDS map");

__device__ __forceinline__ float bf2f(unsigned short v) { return __uint_as_float((unsigned)v << 16); }
__device__ __forceinline__ float wave_sum(float v) {
#pragma unroll
    for (int o = 1; o < 64; o <<= 1) v += __shfl_xor(v, o);
    return v;
}
__device__ __forceinline__ void cvt_item(const float* W, int ldw, int col0, int ncr, bf16* WT, int ldt, int drow, const float* gain, float scale, LAS float* scr, int k0, int n0, int lane) {
    const int n = lane & 31; const bool ok = (n0 + n) < ncr;
    float vv[32];
#pragma unroll
    for (int i = 0; i < 32; ++i) { const int kk = 2 * i + (lane >> 5); vv[i] = ok ? __builtin_nontemporal_load(W + (size_t)(k0 + kk) * ldw + col0 + n0 + n) : 0.f; }
#pragma unroll
    for (int i = 0; i < 32; ++i) { const int kk = 2 * i + (lane >> 5); float v = vv[i] * scale; if (gain) v *= gain[k0 + kk]; scr[kk * 33 + n] = v; }
    LDS_WAIT(); asm volatile("" ::: "memory");
    const int c = lane & 7;
#pragma unroll
    for (int j = 0; j < 4; ++j) { const int nn = (lane >> 3) + 8 * j; const LAS float* s = scr + (8 * c) * 33 + nn;
        v4u o; o.x = pk2(s[0 * 33], s[1 * 33]); o.y = pk2(s[2 * 33], s[3 * 33]); o.z = pk2(s[4 * 33], s[5 * 33]); o.w = pk2(s[6 * 33], s[7 * 33]);
        *(GAS v4u*)(WT + (size_t)(drow + nn) * ldt + k0 + 8 * c) = o; }
    LDS_WAIT(); asm volatile("" ::: "memory");
}
__device__ __forceinline__ void cvt8_load(float (&vv)[32], const float* W, int ldw, int k0, int n0, int lane, int col0 = 0, int ncr = 1 << 30) {
    const int n = lane & 31; const bool ok = (n0 + n) < ncr;
#pragma unroll
    for (int i = 0; i < 32; ++i) { const int kk = 2 * i + (lane >> 5); vv[i] = ok ? __builtin_nontemporal_load(W + (size_t)(k0 + kk) * ldw + col0 + n0 + n) : 0.f; }
}
__device__ __forceinline__ void cvt8_finish(const float (&vv)[32], unsigned char* WT, int ldt, int drow, const float* gain, float scale, LAS float* scr, int k0, int lane) {
    const int n = lane & 31;
#pragma unroll
    for (int i = 0; i < 32; ++i) { const int kk = 2 * i + (lane >> 5); float v = vv[i] * scale; if (gain) v *= gain[k0 + kk]; scr[kk * 33 + n] = v; }
    LDS_WAIT(); asm volatile("" ::: "memory");
    const int c = lane & 7;
#pragma unroll
    for (int j = 0; j < 4; ++j) { const int nn = (lane >> 3) + 8 * j; const LAS float* s = scr + (8 * c) * 33 + nn;
        typedef unsigned u32x2 __attribute__((ext_vector_type(2))); u32x2 o;
        o.x = pg8::pack_fp8x4(s[0 * 33], s[1 * 33], s[2 * 33], s[3 * 33]); o.y = pg8::pack_fp8x4(s[4 * 33], s[5 * 33], s[6 * 33], s[7 * 33]);
        *(GAS u32x2*)(WT + (size_t)(drow + nn) * ldt + k0 + 8 * c) = o; }
    LDS_WAIT(); asm volatile("" ::: "memory");
}
__device__ __forceinline__ void cvt_item8(const float* W, int ldw, unsigned char* WT, int ldt, int drow, const float* gain, float scale, LAS float* scr, int k0, int n0, int lane, int col0 = 0, int ncr = 1 << 30) {
    float vv[32]; cvt8_load(vv, W, ldw, k0, n0, lane, col0, ncr); cvt8_finish(vv, WT, ldt, drow, gain, scale, scr, k0, lane);
}
__device__ __forceinline__ float rms_row_to_bf16(const float* xrow, bf16* orow, int lane) {
    const GAS f32x4* xr = (const GAS f32x4*)xrow + lane;
    f32x4 v[4]; float s = 0.f;
#pragma unroll
    for (int j = 0; j < 4; ++j) { v[j] = __builtin_nontemporal_load(xr + 64 * j); s += (v[j].x * v[j].x + v[j].y * v[j].y) + (v[j].z * v[j].z + v[j].w * v[j].w); }
    const float rstd = 1.0f / sqrtf(wave_sum(s) * (1.f / D) + EPS);
    GAS unsigned long long* o8 = (GAS unsigned long long*)orow + lane;
#pragma unroll
    for (int j = 0; j < 4; ++j) o8[64 * j] = (unsigned long long)pk2(v[j].x * rstd, v[j].y * rstd) | ((unsigned long long)pk2(v[j].z * rstd, v[j].w * rstd) << 32);
    return rstd;
}

struct Args { const float* in[23]; float* out; unsigned char* ws; int ph_lo, ph_hi; };

constexpr int CV_KB = D / 64;
constexpr int CV_A = CV_KB * (2592 / 32), CV_MKV = 2 * CV_KB * 16, CV_B = CV_KB * (2592 / 32), CV_O = 2 * CV_KB * 32, CV_GU = 2 * CV_KB * 88, CV_D = 44 * 32;
constexpr int CV_MG = NEXP * CV_KB * 88, CV_MD = NEXP * 44 * 32;
constexpr int CV_P1 = CV_A + CV_MKV, CV_DENSE = CV_P1 + CV_B + CV_O + CV_GU + CV_D, CV_ALL = CV_DENSE + 2 * CV_MG + CV_MD;
static_assert((2 * CV_MG + CV_MD) % 64 == 0, "expert items come in super-items of 64");
__device__ __forceinline__ void cvt_one(const Args& A, LAS float* scr, int lane, int it) {
    unsigned char* ws = A.ws; constexpr int KB = CV_KB;
    const float* nmix = A.in[2]; const float* nmem = A.in[3]; const float* nffn = A.in[4]; const float* nkv = A.in[5];
    int r = it;
    if (r < CV_A) { const int kb = r / 81, nb = r % 81, n0 = nb * 32, k0 = kb * 64;
        int col0, nloc, ncr = 1 << 30; float sc = 1.f;
        if (n0 < 384) { col0 = 0; nloc = n0; sc = 0.10206207261596575f  ; } else if (n0 < 2304) { col0 = 0; nloc = n0; } else if (n0 < 2560) { col0 = 2320; nloc = n0 - 2304; sc = C2; } else { col0 = 2304; nloc = 0; ncr = 16; }
        cvt_item(A.in[7], 2576, col0, ncr, (bf16*)(ws + WS_WA), D, n0, nmix, sc, scr, k0, nloc, lane); return; } r -= CV_A;
    if (r < CV_MKV) { const int l = r / (KB * 16), rr = r % (KB * 16), kb = rr / 16, nb = rr % 16;
        cvt_item(A.in[14] + (size_t)l * D * 512, 512, 0, 1 << 30, (bf16*)(ws + WS_WMKV), D, 512 * l + nb * 32, nmem + l * D, 1.f, scr, kb * 64, nb * 32, lane); return; } r -= CV_MKV;
    if (r < CV_B) { const int kb = r / 81, nb = r % 81, n0 = nb * 32, k0 = kb * 64; unsigned char* WB = ws + WS_WB;
        if (n0 < 1536) cvt_item8(A.in[12], 1548, WB, D, n0, nkv, F8_SW, scr, k0, n0, lane);
        else if (n0 < 2560) cvt_item8(A.in[11], 1024, WB, D, n0, nmix + D, C2 * F8_SW, scr, k0, n0 - 1536, lane);
        else cvt_item8(A.in[12], 1548, WB, D, 2560, nkv, F8_SW, scr, k0, 0, lane, 1536, 12);
        return; } r -= CV_B;
    if (r < CV_O) { const int l = r / (KB * 32), rr = r % (KB * 32), kb = rr / 32, nb = rr % 32;
        cvt_item(A.in[15] + (size_t)l * D * D, D, 0, 1 << 30, (bf16*)(ws + (l ? WS_WO1 : WS_WO0)), D, nb * 32, nullptr, 1.f, scr, kb * 64, nb * 32, lane); return; } r -= CV_O;
    if (r < CV_GU) { const int up = r / (KB * 88), rr = r % (KB * 88), kb = rr / 88, nb = rr % 88, n0 = nb * 32;
        cvt_item(up ? A.in[17] : A.in[16], FF, 0, 1 << 30, (bf16*)(ws + WS_WGU0), D, 256 * (n0 >> 7) + 128 * up + (n0 & 127), nffn, 1.f, scr, kb * 64, n0, lane);
        return; } r -= CV_GU;
    if (r < CV_D) { const int kb = r / 32, nb = r % 32; cvt_item(A.in[18], D, 0, 1 << 30, (bf16*)(ws + WS_WD0), FF, nb * 32, nullptr, 1.f, scr, kb * 64, nb * 32, lane); return; } r -= CV_D;
    if (r < 2 * CV_MG) { const int up = r / CV_MG, r2 = r % CV_MG, e = r2 / (KB * 88), rr = r2 % (KB * 88), kb = rr / 88, nb = rr % 88, n0 = nb * 32;
        cvt_item8((up ? A.in[21] : A.in[20]) + (size_t)e * D * FF, FF, ws + WS_WGUM + (size_t)e * 5632 * D, D, 256 * (n0 >> 7) + 128 * up + (n0 & 127), nffn + D, F8_SW, scr, kb * 64, n0, lane); return; } r -= 2 * CV_MG;
    { const int e = r / (44 * 32), rr = r % (44 * 32), kb = rr / 32, nb = rr % 32;
        cvt_item8(A.in[22] + (size_t)e * FF * D, D, ws + WS_WDM + (size_t)e * D * FF, FF, nb * 32, nullptr, F8_SW, scr, kb * 64, nb * 32, lane); }
}
struct MoeItem { const float* W; unsigned char* WT; const float* gain; int ldw, ldt, drow, k0, n0; };
__device__ __forceinline__ MoeItem moe_item(const Args& A, int r) {
    MoeItem m; constexpr int KB = CV_KB;
    if (r < 2 * CV_MG) { const int up = r / CV_MG, r2 = r % CV_MG, e = r2 / (KB * 88), rr = r2 % (KB * 88), kb = rr / 88, nb = rr % 88, n0 = nb * 32;
        m.W = (up ? A.in[21] : A.in[20]) + (size_t)e * D * FF; m.ldw = FF; m.WT = A.ws + WS_WGUM + (size_t)e * 5632 * D; m.ldt = D; m.drow = 256 * (n0 >> 7) + 128 * up + (n0 & 127); m.gain = A.in[4] + D; m.k0 = kb * 64; m.n0 = n0; }
    else { r -= 2 * CV_MG; const int e = r / (44 * 32), rr = r % (44 * 32), kb = rr / 32, nb = rr % 32;
        m.W = A.in[22] + (size_t)e * FF * D; m.ldw = D; m.WT = A.ws + WS_WDM + (size_t)e * D * FF; m.ldt = FF; m.drow = nb * 32; m.gain = nullptr; m.k0 = kb * 64; m.n0 = nb * 32; }
    return m;
}
__device__ __forceinline__ void p_moe_weights(const Args& A, LAS unsigned char* lds, int gw, int NGW, int wave, int lane) {
    LAS float* scr = (LAS float*)(lds + RING_OFF + wave * 16384); constexpr int NI = 2 * CV_MG + CV_MD;
    float va[32], vb[32]; int it = gw;
    if (it < NI) { const MoeItem m = moe_item(A, it); cvt8_load(va, m.W, m.ldw, m.k0, m.n0, lane); }
#pragma unroll 1
    for (; it < NI; it += 2 * NGW) {
        if (it + NGW < NI) { const MoeItem m = moe_item(A, it + NGW); cvt8_load(vb, m.W, m.ldw, m.k0, m.n0, lane); }
        { const MoeItem m = moe_item(A, it); cvt8_finish(va, m.WT, m.ldt, m.drow, m.gain, F8_SW, scr, m.k0, lane); }
        if (it + 2 * NGW < NI) { const MoeItem m = moe_item(A, it + 2 * NGW); cvt8_load(va, m.W, m.ldw, m.k0, m.n0, lane); }
        if (it + NGW < NI) { const MoeItem m = moe_item(A, it + NGW); cvt8_finish(vb, m.WT, m.ldt, m.drow, m.gain, F8_SW, scr, m.k0, lane); }
    }
}
__device__ __forceinline__ void p_prologue(const Args& A, LAS unsigned char* lds, int gw, int NGW, int wave, int lane) {
    LAS float* scr = (LAS float*)(lds + RING_OFF + wave * 16384);
    unsigned char* ws = A.ws;
    for (int it = gw; it < CV_P1; it += NGW) cvt_one(A, scr, lane, it);
    { const v4u z = {0u, 0u, 0u, 0u}; bf16* WA = (bf16*)(ws + WS_WA);
      for (int i = gw * 64 + lane; i < 224 * 128; i += NGW * 64) *((GAS v4u*)(WA + (size_t)2592 * D) + i) = z; }
    bf16* XB = (bf16*)(ws + WS_X); bf16* XM = (bf16*)(ws + WS_XM);
    for (int m = gw; m < T; m += NGW) (void)rms_row_to_bf16(A.in[0] + (size_t)m * D, XB + (size_t)m * D, lane);
    for (int m = gw; m < TM; m += NGW) (void)rms_row_to_bf16(A.in[1] + (size_t)m * D, XM + (size_t)m * D, lane);
}
__device__ __forceinline__ void p_dense_weights(const Args& A, LAS unsigned char* lds, int gw, int NGW, int wave, int lane) {
    LAS float* scr = (LAS float*)(lds + RING_OFF + wave * 16384);
    for (int it = CV_P1 + gw; it < CV_DENSE; it += NGW) cvt_one(A, scr, lane, it);
    { const v4u z = {0u, 0u, 0u, 0u}; unsigned char* WB = A.ws + WS_WB;
      for (int i = gw * 64 + lane; i < 224 * 64; i += NGW * 64) *((GAS v4u*)(WB + (size_t)2592 * D) + i) = z; }
}

namespace gla {
typedef short bf16x8 __attribute__((ext_vector_type(8)));
constexpr int SQ = 104, S64 = 72, OSQ = 200;
constexpr int O_QD = 0, O_KD = O_QD + 64 * SQ * 2, O_KR = O_KD + 64 * SQ * 2, O_QR = O_KR + 64 * SQ * 2, O_KLT = O_QR + 64 * SQ * 2, O_VT = O_KLT + 96 * S64 * 2, O_P = O_VT + 192 * S64 * 2, O_ST = O_P + 64 * S64 * 2;
constexpr int O_GLR = O_ST + 192 * SQ * 2, O_W2 = O_GLR + 4096, O_B2 = O_W2 + 6144, O_SEG = O_B2 + 384, O_EBL = O_SEG + 1536, O_BTOT = O_EBL + 384, O_BBASE = O_BTOT + 384, O_END = O_BBASE + 384;
constexpr int O_OS = O_KD;
constexpr int O_OL = 0, O_RL = 64 * OSQ * 2;
static_assert(O_END <= RING_BYTES && 64 * OSQ * 2 <= 2 * 64 * SQ * 2 && 2 * 64 * OSQ * 2 <= O_ST, "gla LDS");
#define MFMA16(a, b, c) __builtin_amdgcn_mfma_f32_16x16x32_bf16((a), (b), (c), 0, 0, 0)
#define FRAG(off) (*(const LAS bf16x8*)(lds + (off)))
__device__ __forceinline__ void pass1(LAS unsigned char* lds, bf16* Y, const float* glrf, const float* w2, const float* b2, float* DS, float* DD, int unit, const bool DRY, unsigned long long* mk = nullptr) {
#define GMARK(i) do { if (mk && tid == 0 && n == 3) mk[i] = __builtin_amdgcn_s_memrealtime(); } while (0)
    const int tid = threadIdx.x, lane = tid & 63, w = __builtin_amdgcn_readfirstlane(tid >> 6), l15 = lane & 15, quad = lane >> 4;
    const int bh = unit >> 4, g = unit & 15, b = bh >> 2, h = bh & 3;
    const size_t row0 = (size_t)b * SEQ + (size_t)g * 512;
    LAS bf16* QD = (LAS bf16*)(lds + O_QD); LAS bf16* KD = (LAS bf16*)(lds + O_KD); LAS bf16* KR = (LAS bf16*)(lds + O_KR); LAS bf16* QR = (LAS bf16*)(lds + O_QR);
    LAS bf16* KLT = (LAS bf16*)(lds + O_KLT); LAS bf16* VT = (LAS bf16*)(lds + O_VT); LAS bf16* P = (LAS bf16*)(lds + O_P); LAS bf16* ST = (LAS bf16*)(lds + O_ST); LAS bf16* OS = (LAS bf16*)(lds + O_OS);
    LAS float* GLR = (LAS float*)(lds + O_GLR); LAS float* W2 = (LAS float*)(lds + O_W2); LAS float* B2 = (LAS float*)(lds + O_B2); LAS float* SEG = (LAS float*)(lds + O_SEG);
    LAS float* EBL = (LAS float*)(lds + O_EBL); LAS float* BTOT = (LAS float*)(lds + O_BTOT); LAS float* BBASE = (LAS float*)(lds + O_BBASE);
    for (int i = tid; i < 16 * 96; i += NTHR) W2[i] = w2[(i / 96) * 384 + h * 96 + (i % 96)];
    if (tid < 96) { B2[tid] = b2[h * 96 + tid]; BBASE[tid] = 0.f; }
    for (int i = tid; i < 192 * SQ * 2 / 16; i += NTHR) ((LAS v4u*)ST)[i] = (v4u){0u, 0u, 0u, 0u};
    f32x4 sacc[9];
#pragma unroll
    for (int i = 0; i < 9; ++i) sacc[i] = (f32x4){0.f, 0.f, 0.f, 0.f};
    v4u qk[3], vv[3]; f32x4 gl = (f32x4){0.f, 0.f, 0.f, 0.f};
#define GLA_LOADS(r0_, tq_) do { _Pragma("unroll") for (int it = 0; it < 3; ++it) { const int i = (tq_) + NTHR * it; const int row = i / 24, c = i % 24; \
        qk[it] = *(const v4u*)(Y + ((r0_) + row) * LDY + (c < 12 ? Y_Q + h * 96 + c * 8 : Y_K + h * 96 + (c - 12) * 8)); \
        vv[it] = *(const v4u*)(Y + ((r0_) + (i & 63)) * LDY + Y_V + h * 192 + (i >> 6) * 8); } \
        if ((tq_) < 256) gl = *(const f32x4*)(glrf + (r0_) * 16 + (tq_) * 4); } while (0)
    GLA_LOADS(row0, tid);
    __syncthreads();
    float w2r[16]; float b2r;
    { const int kc_ = tid % 96;
#pragma unroll
      for (int j = 0; j < 16; ++j) w2r[j] = W2[j * 96 + kc_];
      b2r = B2[kc_]; }
#pragma unroll 1
    for (int n = 0; n < 8; ++n) {
        GMARK(10);
        const size_t r0 = row0 + (size_t)n * 64;
        int tq = tid; asm volatile("" : "+v"(tq));
#pragma unroll
        for (int it = 0; it < 3; ++it) { const int i = tq + NTHR * it; const int row = i / 24, c = i % 24;
            *(LAS v4u*)((c < 12 ? QR : KR) + row * SQ + (c % 12) * 8) = qk[it];
            const v4u v = vv[it]; LAS bf16* d = VT + ((i >> 6) * 8) * S64 + (i & 63);
            d[0 * S64] = (bf16)(v.x & 0xffffu); d[1 * S64] = (bf16)(v.x >> 16); d[2 * S64] = (bf16)(v.y & 0xffffu); d[3 * S64] = (bf16)(v.y >> 16);
            d[4 * S64] = (bf16)(v.z & 0xffffu); d[5 * S64] = (bf16)(v.z >> 16); d[6 * S64] = (bf16)(v.w & 0xffffu); d[7 * S64] = (bf16)(v.w >> 16); }
        if (tq < 256) *(LAS f32x4*)(GLR + tq * 4) = gl;
        if (n < 7) GLA_LOADS(r0 + 64, tq);
        __syncthreads();
        GMARK(11);
        float la[16]; const int seg = tid / 96, kc = tid % 96;
        if (tid < 384) { float run = 0.f;
#pragma unroll
            for (int i = 0; i < 16; ++i) { const int t = seg * 16 + i; float z = b2r; const LAS f32x4* gp = (const LAS f32x4*)(GLR + t * 16);
#pragma unroll
                for (int j4 = 0; j4 < 4; ++j4) { const f32x4 g4 = gp[j4]; z += g4.x * w2r[4 * j4] + g4.y * w2r[4 * j4 + 1] + g4.z * w2r[4 * j4 + 2] + g4.w * w2r[4 * j4 + 3]; }
                const float ls = fminf(z, 0.f) - 0.6931471805599453f * __builtin_amdgcn_logf(1.0f + __builtin_amdgcn_exp2f(-fabsf(z) * LOG2E));
                run += ls * 0.0625f; la[i] = run; }
            SEG[seg * 96 + kc] = run; }
        __syncthreads();
        GMARK(12);
        if (tid < 384) {
            const float s0 = SEG[kc], s1 = SEG[96 + kc], s2 = SEG[192 + kc], s3 = SEG[288 + kc];
            const float pre = (seg > 0 ? s0 : 0.f) + (seg > 1 ? s1 : 0.f) + (seg > 2 ? s2 : 0.f), tot = (s0 + s1) + (s2 + s3), base = BBASE[kc];
            const float etot = __expf(tot), ebase = __expf(base);
            unsigned klp[8];
#pragma unroll
            for (int i = 0; i < 16; ++i) { const int t = seg * 16 + i; const float bt = la[i] + pre;
                const float qv = bf2f(QR[t * SQ + kc]), kv = bf2f(KR[t * SQ + kc]);
                const float e1 = __expf(bt), r1 = __builtin_amdgcn_rcpf(e1), qe = qv * e1, kr = kv * r1;
                const unsigned pq = pg8::cvt_pk_bf16(qe, kr), pb = pg8::cvt_pk_bf16(qe * ebase, kr * etot);
                QD[t * SQ + kc] = (bf16)(pq & 0xffffu); KD[t * SQ + kc] = (bf16)(pq >> 16);
                QR[t * SQ + kc] = (bf16)(pb & 0xffffu);
                const unsigned kl = pb >> 16;
                if (i & 1) klp[i >> 1] |= kl << 16; else klp[i >> 1] = kl; }
            LAS v4u* kd = (LAS v4u*)(KLT + kc * S64 + seg * 16);
            kd[0] = (v4u){klp[0], klp[1], klp[2], klp[3]}; kd[1] = (v4u){klp[4], klp[5], klp[6], klp[7]};
            if (seg == 0) { EBL[kc] = etot; BTOT[kc] = tot; } }
        __syncthreads();
        GMARK(13);
        { const int ti = w >> 1;
#pragma unroll
          for (int jj = 0; jj < 2; ++jj) { const int tj = 2 * (w & 1) + jj; f32x4 acc = (f32x4){0.f, 0.f, 0.f, 0.f};
            if (tj <= ti) {
#pragma unroll
                for (int ks = 0; ks < 3; ++ks) acc = MFMA16(FRAG(O_QD + ((ti * 16 + l15) * SQ + ks * 32 + quad * 8) * 2), FRAG(O_KD + ((tj * 16 + l15) * SQ + ks * 32 + quad * 8) * 2), acc); }
#pragma unroll
            for (int j = 0; j < 4; ++j) { const int t = ti * 16 + 4 * quad + j, s = tj * 16 + l15; P[t * S64 + s] = (bf16)f2bf(s <= t ? acc[j] : 0.f); } } }
        __syncthreads();
        GMARK(14);
        { const int tr = w & 3, vb0 = (w >> 2) * 6;
          bf16x8 pa[2], qa[3];
#pragma unroll
          for (int ks = 0; ks < 2; ++ks) pa[ks] = FRAG(O_P + ((tr * 16 + l15) * S64 + ks * 32 + quad * 8) * 2);
#pragma unroll
          for (int ks = 0; ks < 3; ++ks) qa[ks] = FRAG(O_QD + ((tr * 16 + l15) * SQ + ks * 32 + quad * 8) * 2);
#pragma unroll
          for (int i = 0; i < 6; ++i) { const int vb = vb0 + i; f32x4 acc = (f32x4){0.f, 0.f, 0.f, 0.f};
#pragma unroll
            for (int ks = 0; ks < 2; ++ks) acc = MFMA16(pa[ks], FRAG(O_VT + ((vb * 16 + l15) * S64 + ks * 32 + quad * 8) * 2), acc);
#pragma unroll
            for (int ks = 0; ks < 3; ++ks) acc = MFMA16(qa[ks], FRAG(O_ST + ((vb * 16 + l15) * SQ + ks * 32 + quad * 8) * 2), acc);
            LAS bf16* so = OS + (tr * 16 + 4 * quad) * OSQ + vb * 16 + l15;
#pragma unroll
            for (int j = 0; j < 4; ++j) so[j * OSQ] = (bf16)f2bf(acc[j]); } }
        __syncthreads();
        GMARK(15);
#pragma unroll
        for (int i = 0; i < 9; ++i) { const int idx = w * 9 + i, kb = idx / 12, vb = idx % 12;
            const f32x4 dec = *(const LAS f32x4*)(EBL + kb * 16 + 4 * quad);
            f32x4 acc = sacc[i] * dec;
#pragma unroll
            for (int ks = 0; ks < 2; ++ks) acc = MFMA16(FRAG(O_KLT + ((kb * 16 + l15) * S64 + ks * 32 + quad * 8) * 2), FRAG(O_VT + ((vb * 16 + l15) * S64 + ks * 32 + quad * 8) * 2), acc);
            sacc[i] = acc;
            *(LAS unsigned long long*)(ST + (vb * 16 + l15) * SQ + kb * 16 + 4 * quad) = (unsigned long long)pk2(acc[0], acc[1]) | ((unsigned long long)pk2(acc[2], acc[3]) << 32); }
        int td = tid; asm volatile("" : "+v"(td));
#pragma unroll
        for (int it = 0; it < 3; ++it) { const int i = td + NTHR * it; const int row = i / 24, c = i % 24;
            *(v4u*)(Y + (r0 + row) * LDY + (DRY ? 2592 : Y_V + h * 192) + c * 8) = *(const LAS v4u*)(OS + row * OSQ + c * 8); }
#pragma unroll
        for (int it = 0; it < 2; ++it) { const int i = td + NTHR * it; if (i < 768) { const int row = i / 12, c = i % 12;
            *(v4u*)(Y + (r0 + row) * LDY + (DRY ? 2592 : Y_Q + h * 96) + c * 8) = *(const LAS v4u*)(QR + row * SQ + c * 8); } }
        if (tid < 96) BBASE[tid] += BTOT[tid];
        __syncthreads();
        GMARK(16);
    }
#undef GLA_LOADS
#undef GMARK
#pragma unroll
    for (int i = 0; i < 9; ++i) { const int idx = w * 9 + i, kb = idx / 12, vb = idx % 12; float* d = DS + ((size_t)(unit + (DRY ? 256 : 0)) * 96 + kb * 16 + 4 * quad) * 192 + vb * 16 + l15;
#pragma unroll
        for (int j = 0; j < 4; ++j) d[j * 192] = sacc[i][j]; }
    if (tid < 96) DD[(unit + (DRY ? 256 : 0)) * 96 + tid] = __expf(BBASE[tid]);
    __syncthreads();
}
__device__ __forceinline__ void prefix(float* DS, const float* DD, int unit) {
    const int tid = threadIdx.x, bh = unit >> 4, part = unit & 15;
#pragma unroll 1
    for (int i = 0; i < 3; ++i) { const int e = tid + NTHR * i; if (e < 1152) { const int idx = part * 1152 + e, k = idx / 192;
        float v[16], d[16];
#pragma unroll
        for (int g = 0; g < 16; ++g) { v[g] = DS[(size_t)(bh * 16 + g) * 96 * 192 + idx]; d[g] = DD[(bh * 16 + g) * 96 + k]; }
        float S = 0.f;
#pragma unroll
        for (int g = 0; g < 16; ++g) { DS[(size_t)(bh * 16 + g) * 96 * 192 + idx] = S; S = d[g] * S + v[g]; } } }
}
__device__ __forceinline__ void pass3(LAS unsigned char* lds, bf16* Y, const float* onorm, const float* DS, const float* DD, int unit, const bool DRY) {
    const int tid = threadIdx.x, lane = tid & 63, w = __builtin_amdgcn_readfirstlane(tid >> 6), l15 = lane & 15, quad = lane >> 4;
    const int bh = unit >> 4, g = unit & 15, b = bh >> 2, h = bh & 3;
    const size_t row0 = (size_t)b * SEQ + (size_t)g * 512;
    LAS bf16* ST = (LAS bf16*)(lds + O_ST); LAS float* ON = (LAS float*)(lds + O_GLR); LAS float* SS = (LAS float*)(lds + O_W2);
    LAS bf16* OL = (LAS bf16*)(lds + O_OL); LAS bf16* RL = (LAS bf16*)(lds + O_RL);
    { const float* ds = DS + (size_t)unit * 96 * 192;
#pragma unroll
      for (int i = 0; i < 36; ++i) { const int idx = tid + NTHR * i; ST[(idx % 192) * SQ + idx / 192] = (bf16)f2bf(ds[idx]); } }
    if (tid < 192) ON[tid] = onorm[tid];
    const int tr = w & 3, vb0 = (w >> 2) * 6;
    v4u ol[3], rl[3]; bf16x8 qn[3];
#define GLA_LOADS3(r0_, tq_) do { _Pragma("unroll") for (int it = 0; it < 3; ++it) { const int i = (tq_) + NTHR * it; const int row = i / 24, c = i % 24; \
        ol[it] = *(const v4u*)(Y + ((r0_) + row) * LDY + Y_V + h * 192 + c * 8); rl[it] = *(const v4u*)(Y + ((r0_) + row) * LDY + Y_R + h * 192 + c * 8); } \
        _Pragma("unroll") for (int ks = 0; ks < 3; ++ks) qn[ks] = *(const bf16x8*)(Y + ((r0_) + tr * 16 + l15) * LDY + Y_Q + h * 96 + ks * 32 + quad * 8); } while (0)
    GLA_LOADS3(row0, tid);
    __syncthreads();
#pragma unroll 1
    for (int n = 0; n < 8; ++n) {
        const size_t r0 = row0 + (size_t)n * 64;
        int tq = tid; asm volatile("" : "+v"(tq));
#pragma unroll
        for (int it = 0; it < 3; ++it) { const int i = tq + NTHR * it; const int row = i / 24, c = i % 24;
            *(LAS v4u*)(OL + row * OSQ + c * 8) = ol[it]; *(LAS v4u*)(RL + row * OSQ + c * 8) = rl[it]; }
        bf16x8 qa[3];
#pragma unroll
        for (int ks = 0; ks < 3; ++ks) qa[ks] = qn[ks];
        if (n < 7) GLA_LOADS3(r0 + 64, tq);
        __syncthreads();
        f32x4 acc[6]; float ssq[4] = {0.f, 0.f, 0.f, 0.f};
#pragma unroll
        for (int i = 0; i < 6; ++i) { const int vb = vb0 + i; f32x4 a = (f32x4){0.f, 0.f, 0.f, 0.f};
#pragma unroll
            for (int ks = 0; ks < 3; ++ks) a = MFMA16(qa[ks], FRAG(O_ST + ((vb * 16 + l15) * SQ + ks * 32 + quad * 8) * 2), a);
            const LAS bf16* so = OL + (tr * 16 + 4 * quad) * OSQ + vb * 16 + l15;
#pragma unroll
            for (int j = 0; j < 4; ++j) { a[j] += bf2f(so[j * OSQ]); ssq[j] += a[j] * a[j]; }
            acc[i] = a; }
#pragma unroll
        for (int j = 0; j < 4; ++j) { float v = ssq[j]; v += __shfl_xor(v, 1); v += __shfl_xor(v, 2); v += __shfl_xor(v, 4); v += __shfl_xor(v, 8); ssq[j] = v; }
        if (l15 == 0) {
#pragma unroll
            for (int j = 0; j < 4; ++j) SS[(tr * 16 + 4 * quad + j) * 2 + (w >> 2)] = ssq[j]; }
        __syncthreads();
        float rs[4];
#pragma unroll
        for (int j = 0; j < 4; ++j) { const int t = tr * 16 + 4 * quad + j; rs[j] = 1.0f / sqrtf((SS[t * 2] + SS[t * 2 + 1]) * (1.f / 192.f) + EPS); }
#pragma unroll
        for (int i = 0; i < 6; ++i) { const int dv = (vb0 + i) * 16 + l15; const float gn = ON[dv];
            LAS bf16* so = OL + (tr * 16 + 4 * quad) * OSQ + dv; const LAS bf16* sr = RL + (tr * 16 + 4 * quad) * OSQ + dv;
#pragma unroll
            for (int j = 0; j < 4; ++j) { const float rv = bf2f(sr[j * OSQ]); so[j * OSQ] = (bf16)f2bf(acc[i][j] * rs[j] * gn * pg8::silu_f(rv)); } }
        __syncthreads();
        int td = tid; asm volatile("" : "+v"(td));
#pragma unroll
        for (int it = 0; it < 3; ++it) { const int i = td + NTHR * it; const int row = i / 24, c = i % 24;
            *(v4u*)(Y + (r0 + row) * LDY + (DRY ? 2592 : Y_R + h * 192) + c * 8) = *(const LAS v4u*)(OL + row * OSQ + c * 8); }
    }
#undef GLA_LOADS3
}
#undef MFMA16
#undef FRAG
}

constexpr int N_PHASES = 19;
__global__ void __launch_bounds__(NTHR, 2) fwd_kernel(Args args) {
    extern __shared__ __attribute__((aligned(16))) unsigned char lds_raw[];
    LAS unsigned char* lds = (LAS unsigned char*)lds_raw;
    volatile LAS unsigned* MISC = (volatile LAS unsigned*)(lds + MISC_OFF);
    const int wave = __builtin_amdgcn_readfirstlane((int)threadIdx.x >> 6);
#define PH_TID() int tid = threadIdx.x; asm volatile("" : "+v"(tid)); const int lane = tid & 63; (void)lane
    const int G = gridDim.x; const int bx = blockIdx.x; const int vcu = (G % 8 == 0) ? (bx % 8) * (G / 8) + bx / 8 : bx;
    const int gw = vcu * NWAVES + wave, NGW = G * NWAVES;
    unsigned char* ws = args.ws;
    gu32* ctl = (gu32*)(ws + WS_CTL);
    { PH_TID(); for (int u = tid; u < (LDS_BYTES - LDSCTL_OFF) / 4; u += NTHR) ((LAS unsigned*)(lds + LDSCTL_OFF))[u] = 0u; }
    __syncthreads();
    const bool multi = (args.ph_hi - args.ph_lo) > 1;
    XcdBarrier bar; bar.bar = (unsigned*)(ctl + CW_BAR); bar.x = 0; bar.st = nullptr;
    if (multi) bar = xcd_barrier_post((unsigned*)(ctl + CW_BAR), MISC + 8);
    const int lo = args.ph_lo, hi = args.ph_hi;
#ifdef PROBE_Q
    unsigned long long* stamps = (unsigned long long*)(ws + 768 * 1024);
    if (threadIdx.x == 0 && blockIdx.x == 0) stamps[96] = __builtin_amdgcn_s_memrealtime();
#endif
#define IN(k) (lo <= (k) && (k) < hi)
#ifdef PROBE_Q
#ifndef PROBE_BLK
#define PROBE_BLK 0
#endif
#define MARK(i) do { if (threadIdx.x == 0 && blockIdx.x == PROBE_BLK) stamps[160 + (i)] = __builtin_amdgcn_s_memrealtime(); } while (0)
#define STAMP_BAR(pos) do { if (threadIdx.x == 0) { const unsigned long long t_ = __builtin_amdgcn_s_memrealtime(); atomicMax(stamps + 32 + (pos), t_); atomicMax(stamps + (pos), ~t_); if (blockIdx.x == PROBE_BLK) stamps[128 + (pos)] = t_; } \
        xcd_barrier(bar); if (threadIdx.x == 0 && blockIdx.x == 0) stamps[64 + (pos)] = __builtin_amdgcn_s_memrealtime(); } while (0)
#else
#define STAMP_BAR(pos) xcd_barrier(bar)
#define MARK(i) do { } while (0)
#endif
#define SEAM(k) do { if (IN(k) && IN((k) + 1)) STAMP_BAR((k) <= 2 ? (k) : (k) + 1); } while (0)
#ifndef DUPMASK
#define DUPMASK 0
#endif
#define DUP(k) (((DUPMASK) >> (k)) & 1)
#define DRYBAR() xcd_barrier(bar)
#define REPS(k) _Pragma("unroll 1") for (int rep_ = DUP(k) ? 0 : 1; rep_ < 2; ++rep_)
#define REP_END() do { if (rep_ == 0) DRYBAR(); } while (0)
#define DRYSC(k) (DUP(k) ? (rep_ == 0 ? 0.0f : 1.0f) : 1.0f)

    bf16* Y = (bf16*)(ws + WS_Y); bf16* XB = (bf16*)(ws + WS_X); bf16* HB = (bf16*)(ws + WS_Y);
    float* SIDE = (float*)(ws + WS_SIDE); float* CS = (float*)(ws + WS_CS);
    bf16* MKV = (bf16*)(ws + WS_MKV);
    float* DSb = (float*)(ws + WS_DS); float* DDb = (float*)(ws + WS_DD);
    int* EID = (int*)(ws + WS_EID); float* GWT = (float*)(ws + WS_GW); float* RSTD = (float*)(ws + WS_RSTD);
    int* TOK = (int*)(ws + WS_TOK); float* GATE = (float*)(ws + WS_GATE); int* TILEE = (int*)(ws + WS_TILEE); int* CNTW = (int*)(ws + WS_TILEE + 8192); int* POS = (int*)(ws + WS_POS); float* KTN = (float*)(ws + WS_KT);
    float* OUT = args.out;

    if (IN(0)) { PH_TID(); if (DUP(0)) { p_prologue(args, lds, gw, NGW, wave, lane); DRYBAR(); } p_prologue(args, lds, gw, NGW, wave, lane); }
    SEAM(0);
    if (IN(1)) { REPS(1) {
        { pg8::Gemm g{XB, (const bf16*)(ws + WS_WA), T, LDY, D, D, D, 0}; pg8::StaticOrder S; S.init(T, LDY, G, bx);
          pg8::EpiBf16 E{Y, LDY, SIDE, 10, nullptr, 1.0f};
          pg8::gemm_phase<pg8::EpiBf16, pg8::StaticOrder, true, true>(lds + RING_OFF, g, S, E); }
        { pg8::Gemm g{(const bf16*)(ws + WS_XM), (const bf16*)(ws + WS_WMKV), TM, 1024, D, D, D, 0}; pg8::StaticOrder S; S.init(TM, 1024, G, (bx + G - (G / 2)) % G);
          pg8::EpiBf16 E{MKV, 1024, nullptr, -1, nullptr, 1.0f};
          pg8::gemm_phase<pg8::EpiBf16, pg8::StaticOrder, true, true>(lds + RING_OFF, g, S, E); }
        REP_END(); }
    }
    SEAM(1);
    if (IN(2)) { MARK(0); REPS(2) {
        for (int u = vcu; u < 256; u += G) gla::pass1(lds + RING_OFF, Y, SIDE, args.in[8], args.in[9], DSb, DDb, u, rep_ == 0,
#ifdef PROBE_Q
            blockIdx.x == PROBE_BLK ? stamps + 160 : nullptr
#else
            nullptr
#endif
            );
        REP_END(); }
      MARK(1);
      REPS(20) {
        for (int u = vcu; u < 512; u += G) { const int qblk = u >> 2, h = u & 3, b = qblk >> 5;
            attn_body::attn_unit<8, false, false, LDY, 1024>((long)qblk * 256, (long)b * NMEM, 4, (const attn_body::bf16*)(Y + Y_MQ + h * 64), (const attn_body::bf16*)(MKV + h * 64), (const attn_body::bf16*)(MKV + 256 + h * 64),
                (attn_body::bf16*)(Y + (rep_ == 0 ? 2592 : Y_MQ + h * 64)), nullptr, (char*)lds_raw + RING_OFF); }
        REP_END(); }
      MARK(2);
      { PH_TID(); __syncthreads(); p_dense_weights(args, lds, gw, NGW, wave, lane); __syncthreads(); }
      MARK(3);
    }
    SEAM(2);
    if (IN(3)) { for (int u = vcu; u < 256; u += G) gla::prefix(DSb, DDb, u);
        STAMP_BAR(3);
        REPS(3) { for (int u = vcu; u < 256; u += G) gla::pass3(lds + RING_OFF, Y, args.in[10], DSb, DDb, u, rep_ == 0); REP_END(); } }
    SEAM(3);
    if (IN(4)) { REPS(4) { pg8::Gemm g{Y + MIX_OFF, (const bf16*)(ws + WS_WO0), T, D, D, LDY, D, 0}; pg8::StaticOrder S; S.init(T, D, G, bx);
        typedef pg8::EpiResF32<D, false, 0, 0, true> Epi4; Epi4 E{args.in[0], rep_ == 0 ? (float*)(ws + WS_X) : OUT, ws};
        pg8::gemm_phase<Epi4, pg8::StaticOrder, true, true>(lds + RING_OFF, g, S, E); REP_END(); } }
    SEAM(4);
    if (IN(5)) { PH_TID(); REPS(5) { for (int m = gw; m < T; m += NGW) (void)rms_row_to_bf16(OUT + (size_t)m * D, XB + (size_t)m * D, lane); REP_END(); } }
    SEAM(5);
    if (IN(6)) { REPS(6) { pg8::Gemm g{XB, (const bf16*)(ws + WS_WGU0), T, 2 * FF, D, D, D, 0}; pg8::StaticOrder S; S.init(T, 2 * FF, G, bx);
        pg8::EpiSwiGLU E{HB, FF, nullptr};
        pg8::gemm_phase<pg8::EpiSwiGLU, pg8::StaticOrder, true, true>(lds + RING_OFF, g, S, E); REP_END(); } }
    SEAM(6);
    if (IN(7)) { REPS(7) { pg8::Gemm g{HB, (const bf16*)(ws + WS_WD0), T, D, FF, FF, FF, 0}; pg8::StaticOrder S; S.init(T, D, G, bx);
        typedef pg8::EpiResF32<D, false, 0, 0> Epi7; Epi7 E{OUT, rep_ == 0 ? (float*)(ws + WS_X) : OUT, ws};
        pg8::gemm_phase<Epi7, pg8::StaticOrder, true, true>(lds + RING_OFF, g, S, E); REP_END(); } }
    SEAM(7);
    if (IN(8)) { PH_TID(); REPS(8) { unsigned char* XB8 = ws + WS_X;
        for (int m = gw; m < T; m += NGW) { const GAS f32x4* xr = (const GAS f32x4*)(OUT + (size_t)m * D) + lane; f32x4 v[4]; float s = 0.f;
#pragma unroll
            for (int j = 0; j < 4; ++j) { v[j] = __builtin_nontemporal_load(xr + 64 * j); s += (v[j].x * v[j].x + v[j].y * v[j].y) + (v[j].z * v[j].z + v[j].w * v[j].w); }
            const float rs8 = F8_SA / sqrtf(wave_sum(s) * (1.f / D) + EPS); GAS unsigned* o = (GAS unsigned*)(XB8 + (size_t)m * D) + lane;
#pragma unroll
            for (int j = 0; j < 4; ++j) o[64 * j] = pg8::pack_fp8x4(v[j].x * rs8, v[j].y * rs8, v[j].z * rs8, v[j].w * rs8); }
        REP_END(); } }
    SEAM(8);
    if (IN(9)) { REPS(9) { pg8::Gemm g{XB, (const bf16*)(ws + WS_WB), T, LDY, D / 2, D / 2, D / 2, 0}; pg8::StaticOrder S; S.init(T, LDY, G, bx);
        pg8::EpiBf16 E{Y, LDY, SIDE, 10, nullptr, 1.0f};
        pg8::gemm_phase<pg8::EpiBf16, pg8::StaticOrder, true, true, true, 11>(lds + RING_OFF, g, S, E); REP_END(); } }
    SEAM(9);
    if (IN(10)) { PH_TID(); REPS(10) {
        for (int u = vcu; u < 48; u += G) { const int b = u / 12, h = u % 12; LAS float* sc = (LAS float*)(lds + RING_OFF);
            const float bf = args.in[13][h]; float v[16]; float run = 0.f;
#pragma unroll
            for (int i = 0; i < 16; ++i) { const float z = SIDE[((size_t)b * SEQ + tid * 16 + i) * 16 + h] + bf;
                run += fminf(z, 0.f) - 0.6931471805599453f * __builtin_amdgcn_logf(1.0f + __builtin_amdgcn_exp2f(-fabsf(z) * LOG2E)); v[i] = run; }
            sc[tid] = run; __syncthreads();
            if (tid < 64) { float a[8]; float s = 0.f;
#pragma unroll
                for (int i = 0; i < 8; ++i) { s += sc[tid * 8 + i]; a[i] = s; }
                float incl = s;
#pragma unroll
                for (int o = 1; o < 64; o <<= 1) { const float t2 = __shfl_up(incl, o); if (lane >= o) incl += t2; }
                const float excl = incl - s;
#pragma unroll
                for (int i = 0; i < 8; ++i) sc[512 + tid * 8 + i] = excl + a[i]; }
            __syncthreads();
            const float pre = sc[512 + tid] - run;
#pragma unroll
            for (int i = 0; i < 16; ++i) CS[(size_t)u * SEQ + tid * 16 + i] = (v[i] + pre) * LOG2E;
            __syncthreads(); }
        for (int blk = vcu; blk < T / 128; blk += G) { LAS unsigned* LM = (LAS unsigned*)(lds + RING_OFF) + 2048;
            if (tid < 36) LM[tid] = 0u; else if (tid < 48) LM[tid] = 0xFFFFFFFFu;
            __syncthreads();
            const int r = tid >> 2, part = tid & 3; const bf16* yrow = Y + (size_t)(blk * 128 + r) * LDY;
#pragma unroll
            for (int hh = 0; hh < 3; ++hh) { const int h = part + 4 * hh; const v4u* pk = (const v4u*)(yrow + Z_K + h * 64); const v4u* pq = (const v4u*)(yrow + Z_Q + h * 64); float sk = 0.f, sq = 0.f, dt = 0.f;
#pragma unroll
                for (int c = 0; c < 8; ++c) { const v4u w = pk[c], z = pq[c];
#define BFLO(x) __uint_as_float((x) << 16)
#define BFHI(x) __uint_as_float((x) & 0xffff0000u)
                    const float a0 = BFLO(w.x), a1 = BFHI(w.x), a2 = BFLO(w.y), a3 = BFHI(w.y), a4 = BFLO(w.z), a5 = BFHI(w.z), a6 = BFLO(w.w), a7 = BFHI(w.w);
                    const float b0 = BFLO(z.x), b1 = BFHI(z.x), b2 = BFLO(z.y), b3 = BFHI(z.y), b4 = BFLO(z.z), b5 = BFHI(z.z), b6 = BFLO(z.w), b7 = BFHI(z.w);
#undef BFLO
#undef BFHI
                    sk += ((a0 * a0 + a1 * a1) + (a2 * a2 + a3 * a3)) + ((a4 * a4 + a5 * a5) + (a6 * a6 + a7 * a7));
                    sq += ((b0 * b0 + b1 * b1) + (b2 * b2 + b3 * b3)) + ((b4 * b4 + b5 * b5) + (b6 * b6 + b7 * b7));
                    dt += ((a0 * b0 + a1 * b1) + (a2 * b2 + a3 * b3)) + ((a4 * b4 + a5 * b5) + (a6 * b6 + a7 * b7)); }
                const unsigned db = __float_as_uint(dt), dkey = db ^ ((db >> 31) ? 0xFFFFFFFFu : 0x80000000u);
                __hip_atomic_fetch_max(LM + (r >> 6) * 12 + h, __float_as_uint(sk), __ATOMIC_RELAXED, __HIP_MEMORY_SCOPE_WORKGROUP);
                __hip_atomic_fetch_max(LM + 24 + h, __float_as_uint(sq), __ATOMIC_RELAXED, __HIP_MEMORY_SCOPE_WORKGROUP);
                __hip_atomic_fetch_min(LM + 36 + h, dkey, __ATOMIC_RELAXED, __HIP_MEMORY_SCOPE_WORKGROUP); }
            __syncthreads();
            { const int b = blk >> 6, bl = blk & 63;
              if (tid < 24) KTN[(size_t)(b * 12 + (tid % 12)) * 128 + 2 * bl + tid / 12] = __uint_as_float(LM[tid]);
              else if (tid < 36) KTN[48 * 128 + (size_t)(b * 12 + (tid - 24)) * 64 + bl] = __uint_as_float(LM[tid]);
              else if (tid < 48) { const unsigned k = LM[tid]; KTN[48 * 192 + (size_t)(b * 12 + (tid - 36)) * 64 + bl] = __uint_as_float((k & 0x80000000u) ? (k ^ 0x80000000u) : ~k); } }
            __syncthreads(); }
        for (int u = vcu; u < 512; u += G) { const int qblk = u >> 2, h = u & 3, b = qblk >> 5;
            attn_body::attn_unit<8, false, false, LDY, 1024>((long)qblk * 256, (long)b * NMEM, 4, (const attn_body::bf16*)(Y + Y_MQ + h * 64), (const attn_body::bf16*)(MKV + 512 + h * 64), (const attn_body::bf16*)(MKV + 768 + h * 64),
                (attn_body::bf16*)(Y + (rep_ == 0 ? 2592 : Y_MQ + h * 64)), nullptr, (char*)lds_raw + RING_OFF); }
        REP_END(); }
    }
    SEAM(10);
    if (IN(11)) { MARK(4); REPS(11) {
        LAS int* qs = (LAS int*)(lds + LDSCTL_OFF + 64);
        for (;;) {
            if (threadIdx.x == 0) qs[0] = (int)__hip_atomic_fetch_add(ctl + CW_Q + 64 * rep_, 1u, RLX_AGENT);
            __syncthreads();
            const int slot = __builtin_amdgcn_readfirstlane(qs[0]);
            __syncthreads();
            if (slot >= 1536) break;
            const int ui = slot;
            const int qb = 31 - ui / 48, bh = ui % 48, b = bh / 12, h = bh % 12;
            int NT = 4 * qb + 4, t0 = 0;
            { const int ln = (int)(threadIdx.x & 63u); const float* KTb = KTN + (size_t)bh * 128; const float* csb = CS + (size_t)bh * SEQ;
              const float Qu = sqrtf(fmaxf(KTN[48 * 128 + bh * 64 + 2 * qb], KTN[48 * 128 + bh * 64 + 2 * qb + 1])) * 1.01f;
              const float Kb = sqrtf(fmaxf(fmaxf(KTb[4 * qb], KTb[4 * qb + 1]), fmaxf(KTb[4 * qb + 2], KTb[4 * qb + 3]))) * 1.01f;
              const float c0 = csb[qb * 256];
              const float dmin = fmaxf(fminf(KTN[48 * 192 + bh * 64 + 2 * qb], KTN[48 * 192 + bh * 64 + 2 * qb + 1]) - 0.01f, -Qu * Kb);
              bool ok0 = false, ok1 = false;
              if (ln < NT - 4) ok0 = Qu * (sqrtf(KTb[ln]) * 1.01f) - dmin + c0 - csb[64 * ln + 63] < -FOX_SKIP;
              if (ln + 64 < NT - 4) ok1 = Qu * (sqrtf(KTb[ln + 64]) * 1.01f) - dmin + c0 - csb[64 * (ln + 64) + 63] < -FOX_SKIP;
              const unsigned long long m0 = __ballot(ok0), m1 = __ballot(ok1);
              t0 = (~m0 != 0ull) ? __builtin_ctzll(~m0) : ((~m1 != 0ull) ? 64 + __builtin_ctzll(~m1) : 128);
              t0 = __builtin_amdgcn_readfirstlane(t0); if (t0 > NT - 4) t0 = NT - 4; t0 &= ~1; }
            NT -= t0;
            attn_body::attn_unit<60, true, true, LDY, LDY>((long)b * SEQ + qb * 256, (long)b * SEQ + 64 * t0, NT, (const attn_body::bf16*)(Y + Z_Q + h * 64), (const attn_body::bf16*)(Y + Z_K + h * 64), (const attn_body::bf16*)(Y + Z_V + h * 64),
                (attn_body::bf16*)(Y + (rep_ == 0 ? 2592 : Z_Q + h * 64)), CS + (size_t)bh * SEQ + 64 * t0, (char*)lds_raw + RING_OFF); }
        REP_END(); }
      MARK(5);
      { PH_TID(); __syncthreads(); p_moe_weights(args, lds, gw, NGW, wave, lane); __syncthreads(); }
      MARK(6);
    }
    SEAM(11);
    if (IN(12)) { REPS(12) { pg8::Gemm g{Y + MIX_OFF, (const bf16*)(ws + WS_WO1), T, D, D, LDY, D, 0}; pg8::StaticOrder S; S.init(T, D, G, bx);
        pg8::EpiBf16 E{(bf16*)(ws + WS_X), D, nullptr, -1, nullptr, 1.0f};
        pg8::gemm_phase<pg8::EpiBf16, pg8::StaticOrder, true, true>(lds + RING_OFF, g, S, E); REP_END(); } }
    SEAM(12);
    if (IN(13)) { PH_TID();
        LAS unsigned* lc = (LAS unsigned*)(lds + RING_OFF);
        const float* wr = args.in[19]; const float* gf = args.in[4] + D;
        LAS float* WRL = (LAS float*)(lds + RING_OFF + 4096);
        for (int i = tid; i < 8 * D; i += NTHR) { const int k = i >> 3, e = i & 7, ln = (k & 255) >> 2, j = k >> 8, c = k & 3; WRL[((((j * 4 + c) * 2 + (e >> 2)) * 64 + ln) * 4) + (e & 3)] = wr[i] * gf[k]; }
        for (int blk = vcu; blk < T / 128; blk += G) {
            if (tid < 16) lc[tid] = 0u;
            __syncthreads();
            f32x4 xn[4]; unsigned long long dn[4];
#define P13_LOAD(m_) do { const GAS f32x4* xr_ = (const GAS f32x4*)(OUT + (size_t)(m_) * D) + lane; const GAS unsigned long long* dr_ = (const GAS unsigned long long*)((const bf16*)(ws + WS_X) + (size_t)(m_) * D) + lane; \
        _Pragma("unroll") for (int j = 0; j < 4; ++j) { xn[j] = __builtin_nontemporal_load(xr_ + 64 * j); dn[j] = __builtin_nontemporal_load(dr_ + 64 * j); } } while (0)
            P13_LOAD(blk * 128 + wave * 16);
#pragma unroll 1
            for (int jj = 0; jj < 16; ++jj) { const int m = blk * 128 + wave * 16 + jj;
                GAS f32x4* xr = (GAS f32x4*)(OUT + (size_t)m * D) + lane;
                float s = 0.f; float lg[8]; f32x4 xv[4]; unsigned long long dv[4];
#pragma unroll
                for (int j = 0; j < 4; ++j) { xv[j] = xn[j]; dv[j] = dn[j]; }
                if (jj < 15) P13_LOAD(m + 1);
#pragma unroll
                for (int e = 0; e < 8; ++e) lg[e] = 0.f;
#pragma unroll
                for (int j = 0; j < 4; ++j) { f32x4 v = xv[j]; const unsigned long long dd = dv[j];
                    v.x += __uint_as_float((unsigned)dd << 16); v.y += __uint_as_float((unsigned)dd & 0xffff0000u); v.z += __uint_as_float((unsigned)(dd >> 32) << 16); v.w += __uint_as_float((unsigned)(dd >> 32) & 0xffff0000u);
                    __builtin_nontemporal_store(v, xr + 64 * j); xv[j] = v; s += (v.x * v.x + v.y * v.y) + (v.z * v.z + v.w * v.w);
#pragma unroll
                    for (int c = 0; c < 4; ++c) { const float xc = v[c]; const LAS f32x4* wp = (const LAS f32x4*)(WRL + (((j * 4 + c) * 2) * 64 + lane) * 4); const f32x4 w0 = wp[0], w1 = wp[64];
                        lg[0] += xc * w0.x; lg[1] += xc * w0.y; lg[2] += xc * w0.z; lg[3] += xc * w0.w; lg[4] += xc * w1.x; lg[5] += xc * w1.y; lg[6] += xc * w1.z; lg[7] += xc * w1.w; } }
                const float rstd = 1.0f / sqrtf(wave_sum(s) * (1.f / D) + EPS);
                { GAS unsigned* o8 = (GAS unsigned*)(ws + WS_X + 100 * MiB + (size_t)m * D) + lane; const float rs8 = rstd * F8_SA;
#pragma unroll
                  for (int j = 0; j < 4; ++j) o8[64 * j] = pg8::pack_fp8x4(xv[j].x * rs8, xv[j].y * rs8, xv[j].z * rs8, xv[j].w * rs8); }
#pragma unroll
                for (int e = 0; e < 8; ++e) lg[e] = wave_sum(lg[e]) * rstd;
                int i1 = 0; float v1 = lg[0];
#pragma unroll
                for (int e = 1; e < 8; ++e) if (lg[e] > v1) { v1 = lg[e]; i1 = e; }
                int i2 = -1; float v2 = -INFINITY;
#pragma unroll
                for (int e = 0; e < 8; ++e) if (e != i1 && lg[e] > v2) { v2 = lg[e]; i2 = e; }
                if (lane == 0) { const float w2g = 1.0f / (1.0f + __expf(v1 - v2)); EID[m] = i1 | (i2 << 8); GWT[2 * m] = 1.0f - w2g; GWT[2 * m + 1] = w2g; RSTD[m] = rstd;
                    __hip_atomic_fetch_add(lc + i1, 1u, __ATOMIC_RELAXED, __HIP_MEMORY_SCOPE_WORKGROUP); __hip_atomic_fetch_add(lc + 8 + i2, 1u, __ATOMIC_RELAXED, __HIP_MEMORY_SCOPE_WORKGROUP); }
            }
#undef P13_LOAD
            __syncthreads();
            if (tid < 16) CNTW[blk * 16 + tid] = (int)lc[tid];
            __syncthreads();
        }
    }
    SEAM(13);
    if (IN(14)) { PH_TID();
        LAS int* L = (LAS int*)(lds + RING_OFF);
        for (int i = tid; i < 4096; i += NTHR) L[64 + i] = CNTW[i];
        __syncthreads();
        if (tid < 16) { int tot = 0; for (int w2 = 0; w2 < T / 128; ++w2) tot += L[64 + w2 * 16 + tid]; L[16 + tid] = tot; }
        __syncthreads();
        if (tid < 16) { int o = 0; for (int q = 0; q < tid; ++q) o += (L[16 + q] + 255) & ~255; L[tid] = o; }
        __syncthreads();
        if (bx == 0) {
            for (int i = tid; i < 512; i += NTHR) { int e = 15;
                for (int q = 15; q >= 0; --q) if (i * 256 < L[q] + ((L[16 + q] + 255) & ~255)) e = q;
                TILEE[i] = e & 7; }
            if (tid == 0) TILEE[512] = (L[15] + ((L[16 + 15] + 255) & ~255)) >> 8;
            for (int i = tid; i < 16 * 256; i += NTHR) { const int pe = i >> 8, j = i & 255, c = L[16 + pe], padn = ((c + 255) & ~255) - c;
                if (j < padn) { TOK[L[pe] + c + j] = -1; GATE[L[pe] + c + j] = 0.f; } }
        }
        unsigned char* XS = ws + WS_X;
        for (int blk = vcu; blk < T / 128; blk += G) {
            if (tid < 16) { int pre = 0; for (int w2 = 0; w2 < blk; ++w2) pre += L[64 + w2 * 16 + tid]; L[32 + tid] = L[tid] + pre; }
            int eid = 0;
            if (tid < 128) { eid = EID[blk * 128 + tid]; L[4352 + tid] = eid; }
            __syncthreads();
            if (tid < 128) { const int e0 = eid & 255, e1 = eid >> 8; int r0 = 0, r1 = 0;
                for (int j = 0; j < tid; ++j) { const int ej = L[4352 + j]; r0 += ((ej & 255) == e0) ? 1 : 0; r1 += ((ej >> 8) == e1) ? 1 : 0; }
                const int pos0 = L[32 + e0] + r0, pos1 = L[32 + 8 + e1] + r1, m = blk * 128 + tid;
                L[4480 + tid] = pos0; L[4608 + tid] = pos1; POS[m] = pos0; POS[T + m] = pos1;
                TOK[pos0] = m; TOK[pos1] = m; GATE[pos0] = GWT[2 * m]; GATE[pos1] = GWT[2 * m + 1]; }
            __syncthreads();
            v4u rowv[16];
#pragma unroll
            for (int jj = 0; jj < 16; ++jj) rowv[jj] = __builtin_nontemporal_load((const GAS v4u*)(ws + WS_X + 100 * MiB + (size_t)(blk * 128 + wave * 16 + jj) * D) + lane);
#pragma unroll
            for (int jj = 0; jj < 16; ++jj) { const int i = wave * 16 + jj; const int pos0 = L[4480 + i], pos1 = L[4608 + i];
                *((GAS v4u*)(XS + (size_t)pos0 * D) + lane) = rowv[jj]; *((GAS v4u*)(XS + (size_t)pos1 * D) + lane) = rowv[jj]; }
            __syncthreads();
        }
    }
    SEAM(14);
    if (IN(15)) { LAS int* tl = (LAS int*)(lds + 131072); { PH_TID(); tl[tid] = TILEE[tid]; __syncthreads(); }
      REPS(15) { const int nM = __builtin_amdgcn_readfirstlane(TILEE[512]);
        pg8::Gemm g{(const bf16*)(ws + WS_X), (const bf16*)(ws + WS_WGUM), 2 * MOE_ROWS, 2 * FF, D / 2, D / 2, D / 2, (size_t)2 * FF * D / 2}; pg8::MoeOrder S; S.init(nM, 2 * FF, G, bx, tl);
        pg8::EpiSwiGLU8 E{ws + WS_Y, FF, F8_SH};
        pg8::gemm_phase<pg8::EpiSwiGLU8, pg8::MoeOrder, true, true, true, 11>(lds + RING_OFF, g, S, E); REP_END(); } }
    SEAM(15);
#ifdef PROBE_G2K
    if (IN(16)) { const int nM = __builtin_amdgcn_readfirstlane(TILEE[512]);
        pg8::Gemm g{(const bf16*)(ws + WS_Y), (const bf16*)(ws + WS_WDM), 2 * MOE_ROWS, D, PROBE_G2K, FF / 2, FF / 2, (size_t)D * FF / 2}; pg8::MoeOrder S; S.init(nM, D, G, bx, tl);
        pg8::EpiBf16 E{(bf16*)(ws + WS_X), D, nullptr, -1, nullptr, 1.0f};
        pg8::gemm_phase<pg8::EpiBf16, pg8::MoeOrder, true, true, true, 10>(lds + RING_OFF, g, S, E); xcd_barrier(bar); }
#endif
    if (IN(16)) { LAS int* tl = (LAS int*)(lds + 131072); { PH_TID(); tl[tid] = TILEE[tid]; __syncthreads(); }
      REPS(16) { const int nM = __builtin_amdgcn_readfirstlane(TILEE[512]);
        pg8::Gemm g{(const bf16*)(ws + WS_Y), (const bf16*)(ws + WS_WDM), 2 * MOE_ROWS, D, FF / 2, FF / 2, FF / 2, (size_t)D * FF / 2}; pg8::MoeOrder S; S.init(nM, D, G, bx, tl);
        pg8::EpiGateBf16 E{(bf16*)(ws + WS_X), D, GATE, 1.0f};
        pg8::gemm_phase<pg8::EpiGateBf16, pg8::MoeOrder, true, true, true, 10>(lds + RING_OFF, g, S, E); REP_END(); } }
    if (IN(16) && IN(19)) STAMP_BAR(17);
    if (IN(19)) { PH_TID(); const float* gfin = args.in[6]; const bf16* Y20 = (const bf16*)(ws + WS_X); const bf16* Y21 = Y20;
        for (int m = gw; m < T; m += NGW) { GAS f32x4* xr = (GAS f32x4*)(OUT + (size_t)m * D) + lane; f32x4 v[4]; float s = 0.f;
            const int p0 = POS[m], p1 = POS[T + m];
            const GAS unsigned long long* y0 = (const GAS unsigned long long*)(Y20 + (size_t)p0 * D) + lane; const GAS unsigned long long* y1 = (const GAS unsigned long long*)(Y21 + (size_t)p1 * D) + lane;
#pragma unroll
            for (int j = 0; j < 4; ++j) { const unsigned long long a = __builtin_nontemporal_load(y0 + 64 * j), c = __builtin_nontemporal_load(y1 + 64 * j); f32x4 x = __builtin_nontemporal_load(xr + 64 * j);
                x.x += __uint_as_float((unsigned)a << 16) + __uint_as_float((unsigned)c << 16); x.y += __uint_as_float((unsigned)a & 0xffff0000u) + __uint_as_float((unsigned)c & 0xffff0000u);
                x.z += __uint_as_float((unsigned)(a >> 32) << 16) + __uint_as_float((unsigned)(c >> 32) << 16); x.w += __uint_as_float((unsigned)(a >> 32) & 0xffff0000u) + __uint_as_float((unsigned)(c >> 32) & 0xffff0000u);
                v[j] = x; s += (x.x * x.x + x.y * x.y) + (x.z * x.z + x.w * x.w); }
            const float rstd = 1.0f / sqrtf(wave_sum(s) * (1.f / D) + EPS);
#pragma unroll
            for (int j = 0; j < 4; ++j) { const f32x4 gg = *(const f32x4*)(gfin + 4 * lane + 256 * j); __builtin_nontemporal_store(v[j] * rstd * gg, xr + 64 * j); } } }
#ifdef PROBE_Q
    if (threadIdx.x == 0 && blockIdx.x == 0) { const unsigned long long tend = __builtin_amdgcn_s_memrealtime(); unsigned long long Q = 0;
        for (int j = 0; j < 18; ++j) { const unsigned long long F = ~__hip_atomic_load(stamps + j, RLX_AGENT), L = __hip_atomic_load(stamps + 32 + j, RLX_AGENT), R = stamps[64 + j], Rp = j ? stamps[64 + j - 1] : stamps[96];
            if (PROBE_Q == 1) Q += R - L;
            else if (PROBE_Q == 2) Q += L - F;
            else if (PROBE_Q == 3 && j == PROBE_P) Q += L - Rp;
            else if (PROBE_Q == 4 && j == PROBE_P) Q += L - F;
            else if (PROBE_Q == 5 && j == PROBE_P) Q += R - L;
            else if (PROBE_Q == 7 && j == 0) Q += stamps[160 + PROBE_P + 1] - stamps[160 + PROBE_P];
            else if (PROBE_Q == 6 && j == PROBE_P) Q += __hip_atomic_load(stamps + 128 + j, RLX_AGENT) - Rp; }
        if (PROBE_Q == 3 && PROBE_P == 18) Q = tend - stamps[64 + 17];
        while (__builtin_amdgcn_s_memrealtime() - tend < (unsigned long long)PROBE_AMP * Q) __builtin_amdgcn_s_sleep(8); }
#endif
#undef IN
#undef SEAM
#undef PH_TID
#undef REPS
#undef DRYSC
#undef REP_END
}

#ifndef MK_PER_PHASE
#define MK_PER_PHASE 0
#endif
extern "C" void kernel_launch(void* const* d_in, const int* in_sizes, int n_in, void* d_out, int out_size, void* d_ws, size_t ws_size, hipStream_t stream) {
    static int grid = 0;
    if (grid == 0) {
        if (n_in != 23 || in_sizes[0] != T * D || out_size != T * D || ws_size < WS_END) { fprintf(stderr, "kernel_launch: unexpected shapes (n_in %d, in0 %d, out %d, ws %zu)\n", n_in, n_in > 0 ? in_sizes[0] : -1, out_size, ws_size); grid = -1; return; }
        int dev = 0, cus = 0, per_cu = 0;
        if (hipGetDevice(&dev) != hipSuccess || hipDeviceGetAttribute(&cus, hipDeviceAttributeMultiprocessorCount, dev) != hipSuccess) { grid = -1; return; }
        if (hipFuncSetAttribute((const void*)fwd_kernel, hipFuncAttributeMaxDynamicSharedMemorySize, LDS_BYTES) != hipSuccess) { fprintf(stderr, "kernel_launch: hipFuncSetAttribute failed\n"); grid = -1; return; }
        if (hipOccupancyMaxActiveBlocksPerMultiprocessor(&per_cu, (const void*)fwd_kernel, NTHR, LDS_BYTES) != hipSuccess || per_cu < 1) fprintf(stderr, "kernel_launch: occupancy query says %d\n", per_cu);
        (void)hipGetLastError();
        grid = cus;
    }
    if (grid < 0) return;
    if (hipMemsetAsync((char*)d_ws + WS_CTL, 0, CTL_ZERO_BYTES, stream) != hipSuccess) return;
    Args a{};
    for (int i = 0; i < 23; ++i) a.in[i] = (const float*)d_in[i];
    a.out = (float*)d_out; a.ws = (unsigned char*)d_ws;
#if MK_PER_PHASE
    for (int p = 0; p <= N_PHASES; ++p) { a.ph_lo = p; a.ph_hi = p + 1; hipLaunchKernelGGL(fwd_kernel, dim3(grid), dim3(NTHR), LDS_BYTES, stream, a); }
#else
    a.ph_lo = 0; a.ph_hi = N_PHASES + 1;
    hipLaunchKernelGGL(fwd_kernel, dim3(grid), dim3(NTHR), LDS_BYTES, stream, a);
#endif
}
```

```cpp
#include <hip/hip_runtime.h>
#include <hip/hip_bf16.h>
#include <cstdio>
#include <cstdint>
#include <cmath>
namespace pg8 {
#define PG8_LAS __attribute__((address_space(3)))
typedef unsigned short bf16_t;
typedef short bf16x8 __attribute__((ext_vector_type(8)));
typedef float f32x4 __attribute__((ext_vector_type(4)));
typedef unsigned u32x4 __attribute__((ext_vector_type(4)));
constexpr int BM = 256, BK = 64, HALF = 128, HTB = HALF * BK * 2  , STAGE_BYTES = 8 * HTB, NXCD = 8, WGM = 4;

__host__ __device__ __forceinline__ int lds_byte(int r, int c) { const int st = (r >> 4) * 2 + (c >> 5), rr = r & 15, cc = c & 31, ob = rr * 64 + cc * 2; return st * 1024 + (ob ^ (((ob >> 9) & 1) << 5)); }
__host__ __device__ __forceinline__ void stage_rc(int b, int& R, int& C) { const int st = b / 1024, sb = b % 1024, swz = sb ^ (((sb >> 9) & 1) << 5); R = (st >> 1) * 16 + swz / 64; C = (st & 1) * 32 + (swz % 64) / 2; }
__host__ __device__ __forceinline__ int perm32(int rho) { const int n = rho >> 4, i = rho & 15; return 8 * (i >> 2) + 4 * n + (i & 3); }

struct Unit { int pm, pn, e; };
struct Gemm { const bf16_t* A; const bf16_t* Bt; int M, N, K, lda, ldb; size_t bes; };

struct StaticOrder {
    int nM, nN, nwg, G, c, wgm = WGM;
    __host__ __device__ void init(int M, int N, int G_, int c_) { nM = M / BM; nN = N / BM; nwg = nM * nN; G = G_; c = c_; }
    __host__ __device__ bool next(int i, Unit& u) const {
        const long L = (long)i * G + c; if (L >= nwg) return false;
        int wgid = (int)L; { const int q = nwg / NXCD, r = nwg % NXCD, xcd = wgid % NXCD, off = wgid / NXCD; wgid = (xcd < r ? xcd * (q + 1) : r * (q + 1) + (xcd - r) * q) + off; }
        const int nig = wgm * nN, gid = wgid / nig, fm = gid * wgm, gsz = (nM - fm) < wgm ? (nM - fm) : wgm;
        u.pm = fm + ((wgid % nig) % gsz); u.pn = (wgid % nig) / gsz; u.e = 0; return true;
    }
    __device__ __forceinline__ void a_ready(const Unit&) const {}
    __device__ __forceinline__ void done(const Unit&) const {}
};

__device__ __forceinline__ unsigned cvt_pk_bf16(float lo, float hi) { unsigned r; asm volatile("v_cvt_pk_bf16_f32 %0, %1, %2" : "=v"(r) : "v"(lo), "v"(hi)); return r; }
typedef float f32x2 __attribute__((ext_vector_type(2)));
__device__ __forceinline__ float rstd16(const float* ss, int row) { const f32x4* p = (const f32x4*)(ss + (size_t)row * 16); const f32x4 a = p[0], b = p[1], c = p[2], d = p[3];
    const float s = (((a[0] + a[1]) + (a[2] + a[3])) + ((b[0] + b[1]) + (b[2] + b[3]))) + (((c[0] + c[1]) + (c[2] + c[3])) + ((d[0] + d[1]) + (d[2] + d[3]))); return 1.0f / sqrtf(s * (1.0f / 1024.0f) + 1e-6f); }
struct EpiBf16 {
    static constexpr bool PERM = true, AFTER_DRAIN = false;
    bf16_t* O; int ldc; float* side; int side_pn; const float* ss; float scl;
    __device__ __forceinline__ void operator()(const f32x4 (&acc)[2][2][4][2], const Unit& u, int wr, int wc, int fr, int fq) const {
        const int row0 = u.pm * BM + wr * 64 + fr; const int col0 = u.pn * BM + wc * 32 + 8 * fq;
#pragma unroll
        for (int ai = 0; ai < 2; ++ai)
#pragma unroll
            for (int m = 0; m < 4; ++m) { bf16_t* rowp = O + (size_t)(row0 + ai * HALF + m * 16) * ldc + col0;
                const float rs = (ss ? rstd16(ss, row0 + ai * HALF + m * 16) : 1.0f) * scl;
#pragma unroll
                for (int bj = 0; bj < 2; ++bj) { const f32x4 v0 = acc[ai][bj][m][0] * rs, v1 = acc[ai][bj][m][1] * rs;
                    u32x4 w; w.x = cvt_pk_bf16(v0[0], v0[1]); w.y = cvt_pk_bf16(v0[2], v0[3]); w.z = cvt_pk_bf16(v1[0], v1[1]); w.w = cvt_pk_bf16(v1[2], v1[3]);
                    *(u32x4*)(rowp + bj * HALF) = w; } }
        if (side != nullptr && u.pn == side_pn && wc == 0 && fq < 2) {
#pragma unroll
            for (int ai = 0; ai < 2; ++ai)
#pragma unroll
                for (int m = 0; m < 4; ++m) { float* sp = side + (size_t)(row0 + ai * HALF + m * 16) * 16 + 8 * fq;
                    const float rs = (ss ? rstd16(ss, row0 + ai * HALF + m * 16) : 1.0f) * scl;
                    *(f32x4*)(sp) = acc[ai][0][m][0] * rs; *(f32x4*)(sp + 4) = acc[ai][0][m][1] * rs; }
        }
    }
};
template <int LDC, bool HAS_XB, size_t XBO, size_t SSO, bool NTBASE = false> struct EpiResF32 {
    static constexpr bool PERM = false, AFTER_DRAIN = false; static constexpr int ldc = LDC;
    const float* base; float* out; unsigned char* wsb;
    __device__ __forceinline__ void operator()(const f32x4 (&acc)[2][2][4][2], const Unit& u, int wr, int wc, int fr, int fq) const {
        asm volatile("" : "+v"(fr), "+v"(fq));
        const int row0 = u.pm * BM + wr * 64 + fr, col0 = u.pn * BM + wc * 32 + 4 * fq;
#pragma unroll
        for (int ai = 0; ai < 2; ++ai) {
            f32x4 bv[4][2][2];
#pragma unroll
            for (int m = 0; m < 4; ++m) { const size_t off = (size_t)(row0 + ai * HALF + m * 16) * ldc + col0;
#pragma unroll
                for (int bj = 0; bj < 2; ++bj)
#pragma unroll
                    for (int n = 0; n < 2; ++n) bv[m][bj][n] = NTBASE ? __builtin_nontemporal_load((const f32x4*)(base + off + bj * HALF + n * 16)) : *(const f32x4*)(base + off + bj * HALF + n * 16); }
#pragma unroll
            for (int m = 0; m < 4; ++m) { const size_t off = (size_t)(row0 + ai * HALF + m * 16) * ldc + col0;
#pragma unroll
                for (int bj = 0; bj < 2; ++bj)
#pragma unroll
                    for (int n = 0; n < 2; ++n) *(f32x4*)(out + off + bj * HALF + n * 16) = bv[m][bj][n] + acc[ai][bj][m][n]; }
            asm volatile("" ::: "memory"); }
    }
};
__device__ __forceinline__ float silu_f(float g) { return g * __builtin_amdgcn_rcpf(1.0f + __builtin_amdgcn_exp2f(-1.4426950408889634f * g)); }
struct EpiSwiGLU {
    static constexpr bool PERM = true, AFTER_DRAIN = false;
    bf16_t* H; int ldh; const float* ss;
    typedef float f32x2 __attribute__((ext_vector_type(2)));
    static __device__ __forceinline__ unsigned two(f32x2 g, f32x2 u) {
        const f32x2 e = g * (-1.4426950408889634f); f32x2 t; t.x = __builtin_amdgcn_exp2f(e.x); t.y = __builtin_amdgcn_exp2f(e.y);
        const f32x2 d = t + 1.0f; f32x2 r; r.x = __builtin_amdgcn_rcpf(d.x); r.y = __builtin_amdgcn_rcpf(d.y);
        const f32x2 o = (g * u) * r; return cvt_pk_bf16(o.x, o.y);
    }
    __device__ __forceinline__ void operator()(const f32x4 (&acc)[2][2][4][2], const Unit& u, int wr, int wc, int fr, int fq) const {
        const int row0 = u.pm * BM + wr * 64 + fr; const int col0 = u.pn * HALF + wc * 32 + 8 * fq;
#pragma unroll
        for (int ai = 0; ai < 2; ++ai)
#pragma unroll
            for (int m = 0; m < 4; ++m) { bf16_t* rowp = H + (size_t)(row0 + ai * HALF + m * 16) * ldh + col0;
                f32x4 g0 = acc[ai][0][m][0], g1 = acc[ai][0][m][1], u0 = acc[ai][1][m][0], u1 = acc[ai][1][m][1];
                if (ss) { const float rs = rstd16(ss, row0 + ai * HALF + m * 16); g0 *= rs; g1 *= rs; u0 *= rs; u1 *= rs; }
                u32x4 w; w.x = two((f32x2){g0[0], g0[1]}, (f32x2){u0[0], u0[1]}); w.y = two((f32x2){g0[2], g0[3]}, (f32x2){u0[2], u0[3]});
                w.z = two((f32x2){g1[0], g1[1]}, (f32x2){u1[0], u1[1]}); w.w = two((f32x2){g1[2], g1[3]}, (f32x2){u1[2], u1[3]});
                *(u32x4*)rowp = w; }
    }
};
struct EpiScatter {
    static constexpr bool PERM = false, AFTER_DRAIN = false;
    const int* tok; const float* gate; float* out; int ldc; float sc;
    __device__ __forceinline__ void operator()(const f32x4 (&acc)[2][2][4][2], const Unit& u, int wr, int wc, int fr, int fq) const {
        const int row0 = u.pm * BM + wr * 64 + fr, col0 = u.pn * BM + wc * 32 + 4 * fq;
#pragma unroll
        for (int ai = 0; ai < 2; ++ai)
#pragma unroll
            for (int m = 0; m < 4; ++m) { const int r = row0 + ai * HALF + m * 16; const int t = tok[r]; const float gw = gate[r] * sc;
                if (t >= 0) { const size_t off = (size_t)t * ldc + col0;
#pragma unroll
                    for (int bj = 0; bj < 2; ++bj)
#pragma unroll
                        for (int n = 0; n < 2; ++n) { const f32x4 b = *(const f32x4*)(out + off + bj * HALF + n * 16); *(f32x4*)(out + off + bj * HALF + n * 16) = b + acc[ai][bj][m][n] * gw; } }
                if (m & 1) asm volatile("" ::: "memory"); }
    }
};
typedef int i32x8 __attribute__((ext_vector_type(8))); typedef int i32x4 __attribute__((ext_vector_type(4)));
__device__ __forceinline__ i32x8 cat8(bf16x8 a, bf16x8 b) { return __builtin_shufflevector(__builtin_bit_cast(i32x4, a), __builtin_bit_cast(i32x4, b), 0, 1, 2, 3, 4, 5, 6, 7); }
__device__ __forceinline__ void mfma8(f32x4& acc, const i32x8& a, const i32x8& b, int sa, int sb) { asm volatile("v_mfma_scale_f32_16x16x128_f8f6f4 %0, %1, %2, %0, %3, %4 op_sel_hi:[0,0,0]" : "+v"(acc) : "v"(a), "v"(b), "v"(sa), "v"(sb)); }
__device__ __forceinline__ float clamp8(float v) { return __builtin_fminf(__builtin_fmaxf(v, -448.f), 448.f); }
__device__ __forceinline__ unsigned pack_fp8x4(float a, float b, float c, float d) { int p = __builtin_amdgcn_cvt_pk_fp8_f32(clamp8(a), clamp8(b), 0, false); return (unsigned)__builtin_amdgcn_cvt_pk_fp8_f32(clamp8(c), clamp8(d), p, true); }
struct EpiSwiGLU8 {
    static constexpr bool PERM = true, AFTER_DRAIN = false;
    unsigned char* H; int ldh; float hs;
    typedef float f32x2 __attribute__((ext_vector_type(2)));
    template <bool HI> static __device__ __forceinline__ unsigned two(f32x2 g, f32x2 u, float hs_, unsigned old) {
        const f32x2 e = g * (-1.4426950408889634f); f32x2 t; t.x = __builtin_amdgcn_exp2f(e.x); t.y = __builtin_amdgcn_exp2f(e.y);
        const f32x2 d = t + 1.0f; f32x2 r; r.x = __builtin_amdgcn_rcpf(d.x); r.y = __builtin_amdgcn_rcpf(d.y);
        const f32x2 o = ((g * u) * r) * hs_;
        return (unsigned)__builtin_amdgcn_cvt_pk_fp8_f32(__builtin_amdgcn_fmed3f(o.x, -448.f, 448.f), __builtin_amdgcn_fmed3f(o.y, -448.f, 448.f), (int)old, HI);
    }
    __device__ __forceinline__ void operator()(const f32x4 (&acc)[2][2][4][2], const Unit& u, int wr, int wc, int fr, int fq) const {
        const int row0 = u.pm * BM + wr * 64 + fr; const int col0 = u.pn * HALF + wc * 32 + 8 * fq;
#pragma unroll
        for (int ai = 0; ai < 2; ++ai)
#pragma unroll
            for (int m = 0; m < 4; ++m) { unsigned char* rowp = H + (size_t)(row0 + ai * HALF + m * 16) * ldh + col0;
                const f32x4 g0 = acc[ai][0][m][0], g1 = acc[ai][0][m][1], u0 = acc[ai][1][m][0], u1 = acc[ai][1][m][1];
                typedef unsigned u32x2 __attribute__((ext_vector_type(2))); u32x2 w;
                w.x = two<false>((f32x2){g0[0], g0[1]}, (f32x2){u0[0], u0[1]}, hs, 0u); w.x = two<true>((f32x2){g0[2], g0[3]}, (f32x2){u0[2], u0[3]}, hs, w.x);
                w.y = two<false>((f32x2){g1[0], g1[1]}, (f32x2){u1[0], u1[1]}, hs, 0u); w.y = two<true>((f32x2){g1[2], g1[3]}, (f32x2){u1[2], u1[3]}, hs, w.y);
                *(u32x2*)rowp = w; }
    }
};
struct EpiGateBf16 {
    static constexpr bool PERM = true, AFTER_DRAIN = false;
    bf16_t* O; int ldc; const float* gate; float sc;
    __device__ __forceinline__ void operator()(const f32x4 (&acc)[2][2][4][2], const Unit& u, int wr, int wc, int fr, int fq) const {
        const int row0 = u.pm * BM + wr * 64 + fr; const int col0 = u.pn * BM + wc * 32 + 8 * fq;
        float gws[2][4];
#pragma unroll
        for (int ai = 0; ai < 2; ++ai)
#pragma unroll
            for (int m = 0; m < 4; ++m) gws[ai][m] = gate[row0 + ai * HALF + m * 16] * sc;
#pragma unroll
        for (int ai = 0; ai < 2; ++ai)
#pragma unroll
            for (int m = 0; m < 4; ++m) { const int r = row0 + ai * HALF + m * 16; const float gw = gws[ai][m]; bf16_t* rowp = O + (size_t)r * ldc + col0;
#pragma unroll
                for (int bj = 0; bj < 2; ++bj) { const f32x4 v0 = acc[ai][bj][m][0] * gw, v1 = acc[ai][bj][m][1] * gw;
                    u32x4 w; w.x = cvt_pk_bf16(v0[0], v0[1]); w.y = cvt_pk_bf16(v0[2], v0[3]); w.z = cvt_pk_bf16(v1[0], v1[1]); w.w = cvt_pk_bf16(v1[2], v1[3]);
                    *(u32x4*)(rowp + bj * HALF) = w; } }
    }
};
struct MoeOrder {
    StaticOrder so; const PG8_LAS int* tile_e; const PG8_LAS int* ft = nullptr;
    __device__ void init(int nM, int N, int G_, int c_, const PG8_LAS int* te) { so.nM = nM; so.nN = N / BM; so.nwg = nM * so.nN; so.G = G_; so.c = c_; tile_e = te; }
    __device__ bool next(int i, Unit& u) const { if (!so.next(i, u)) return false; if (ft) u.pm = __builtin_amdgcn_readfirstlane(ft[u.pm]); u.e = __builtin_amdgcn_readfirstlane(tile_e[u.pm]); return true; }
    __device__ __forceinline__ void a_ready(const Unit&) const {}
    __device__ __forceinline__ void done(const Unit&) const {}
};
template <class Epi, class Sched, bool ALIGN_EPI = false, bool SP2 = false, bool F8 = false, int F8SHIFT = 0>
__device__ __forceinline__ void gemm_phase(PG8_LAS unsigned char* lds, const Gemm g, const Sched& S, const Epi& E, unsigned long long* mk = nullptr) {
    const int tid = threadIdx.x, wid = __builtin_amdgcn_readfirstlane(tid >> 6), lane = tid & 63, wr = wid >> 2, wc = wid & 3, fr = lane & 15, fq = lane >> 4;
    const int K = g.K, nt = K / BK;
    unsigned voffA[2], voffB[2];
#pragma unroll
    for (int i = 0; i < 2; ++i) { int R, C; stage_rc(tid * 16 + i * 8192, R, C); const int Rb = Epi::PERM ? ((R & ~31) + perm32(R & 31)) : R;
        voffA[i] = (unsigned)(R * g.lda + C) * 2u; voffB[i] = (unsigned)(Rb * g.ldb + C) * 2u; }
    const size_t kstep = (size_t)(BK * 2);
    const size_t hstepA = (size_t)HALF * g.lda * 2, hstepB = (size_t)HALF * g.ldb * 2;
    const size_t tstepA = 2 * hstepA, tstepB = 2 * hstepB, estepB = g.bes * 2;
    const unsigned ldsw = (unsigned)wid * 1024u;
    const int aoff = lds_byte(wr * 64 + fr, fq * 8), boff = lds_byte(wc * 32 + fr, fq * 8);
#define PG8_SA(b, h) (((b) * 2 + (h)) * HTB)
#define PG8_SB(b, h) ((4 + (b) * 2 + (h)) * HTB)
#define PG8_STAGE(bufoff, gbase, voff) do { _Pragma("unroll") for (int _i = 0; _i < 2; ++_i) \
        __builtin_amdgcn_global_load_lds((const unsigned*)((const char*)(gbase) + (voff)[_i]), (PG8_LAS unsigned*)(lds + (bufoff) + ldsw + _i * 8192), 16, 0, 0); } while (0)
#define PG8_LDA(dst, b, h) do { _Pragma("unroll") for (int m = 0; m < 4; ++m) { if constexpr (F8) dst##8[m] = cat8(*(const PG8_LAS bf16x8*)(lds + PG8_SA(b, h) + aoff + m * 2048), *(const PG8_LAS bf16x8*)(lds + PG8_SA(b, h) + aoff + m * 2048 + 1024)); \
        else { _Pragma("unroll") for (int k = 0; k < 2; ++k) dst[m][k] = *(const PG8_LAS bf16x8*)(lds + PG8_SA(b, h) + aoff + m * 2048 + k * 1024); } } } while (0)
#define PG8_LDB(dst, b, h) do { _Pragma("unroll") for (int n = 0; n < 2; ++n) { if constexpr (F8) dst##8[n] = cat8(*(const PG8_LAS bf16x8*)(lds + PG8_SB(b, h) + boff + n * 2048), *(const PG8_LAS bf16x8*)(lds + PG8_SB(b, h) + boff + n * 2048 + 1024)); \
        else { _Pragma("unroll") for (int k = 0; k < 2; ++k) dst[n][k] = *(const PG8_LAS bf16x8*)(lds + PG8_SB(b, h) + boff + n * 2048 + k * 1024); } } } while (0)
#define PG8_MMA(ai, bj, At, Bt) do { __builtin_amdgcn_s_setprio(1); _Pragma("unroll") for (int m = 0; m < 4; ++m) _Pragma("unroll") for (int n = 0; n < 2; ++n) { \
        if constexpr (F8) mfma8(acc[ai][bj][m][n], Bt##8[n], At##8[m], one8, scl8); \
        else { _Pragma("unroll") for (int k = 0; k < 2; ++k) acc[ai][bj][m][n] = __builtin_amdgcn_mfma_f32_16x16x32_bf16(Bt[n][k], At[m][k], acc[ai][bj][m][n], 0, 0, 0); } } __builtin_amdgcn_s_setprio(0); } while (0)
#define PG8_WAIT_V(n) asm volatile("s_waitcnt vmcnt(" #n ")" ::: "memory")
#define PG8_WAIT_L(n) asm volatile("s_waitcnt lgkmcnt(" #n ")" ::: "memory")
#define PG8_BAR __builtin_amdgcn_s_barrier()
#define PG8_SCHED __builtin_amdgcn_sched_barrier(0)
    Unit cur, nxt; int ui = 0;
    if (mk && threadIdx.x == 0) mk[0] = __builtin_amdgcn_s_memrealtime();
    if (!S.next(0, cur)) return;
    f32x4 acc[2][2][4][2];
#pragma unroll
    for (int a = 0; a < 2; ++a)
#pragma unroll
        for (int b = 0; b < 2; ++b)
#pragma unroll
            for (int m = 0; m < 4; ++m)
#pragma unroll
                for (int n = 0; n < 2; ++n) acc[a][b][m][n] = (f32x4){0.f, 0.f, 0.f, 0.f};
    bf16x8 At[4][2], B0[2][2], B1[2][2];
    int one8 = 0x7F7F7F7F, scl8 = 0x01010101 * (127 - F8SHIFT); asm volatile("" : "+v"(one8), "+v"(scl8));
    i32x8 At8[4], B08[2], B18[2];
    const char* cA = (const char*)g.A + (size_t)cur.pm * tstepA; const char* cB = (const char*)g.Bt + (size_t)cur.e * estepB + (size_t)cur.pn * tstepB;
    S.a_ready(cur);
    if constexpr (SP2) {
        PG8_STAGE(PG8_SB(0, 0), cB, voffB); PG8_STAGE(PG8_SB(0, 1), cB + hstepB, voffB); PG8_STAGE(PG8_SA(0, 0), cA, voffA); PG8_STAGE(PG8_SA(0, 1), cA + hstepA, voffA);
        if (wr == 1) PG8_BAR;
        PG8_WAIT_V(2); PG8_BAR;
        PG8_STAGE(PG8_SB(1, 0), cB + kstep, voffB); PG8_STAGE(PG8_SA(1, 0), cA + kstep, voffA); PG8_STAGE(PG8_SB(1, 1), cB + hstepB + kstep, voffB);
        PG8_WAIT_V(6); PG8_BAR;
    } else {
        PG8_STAGE(PG8_SB(0, 0), cB, voffB); PG8_STAGE(PG8_SA(0, 0), cA, voffA); PG8_STAGE(PG8_SB(0, 1), cB + hstepB, voffB); PG8_STAGE(PG8_SA(0, 1), cA + hstepA, voffA);
        if (wr == 1) PG8_BAR;
        PG8_WAIT_V(4); PG8_BAR;
        PG8_STAGE(PG8_SB(1, 0), cB + kstep, voffB); PG8_STAGE(PG8_SA(1, 0), cA + kstep, voffA); PG8_STAGE(PG8_SB(1, 1), cB + hstepB + kstep, voffB);
        PG8_WAIT_V(6); PG8_BAR;
    }
    for (;;) {
        const bool has_next = S.next(ui + 1, nxt);
        const char* nA = has_next ? (const char*)g.A + (size_t)nxt.pm * tstepA : cA; const char* nB = has_next ? (const char*)g.Bt + (size_t)nxt.e * estepB + (size_t)nxt.pn * tstepB : cB;
#pragma clang loop unroll(disable)
        for (int t = 0; t < nt; t += 2) {
            const bool last = (t == nt - 2);
            const char* a1 = cA + (size_t)(t + 1) * kstep;
            const char* a2 = last ? nA : cA + (size_t)(t + 2) * kstep; const char* b2 = last ? nB : cB + (size_t)(t + 2) * kstep;
            const char* a3 = a2 + kstep; const char* b3 = b2 + kstep;
            if (last && has_next) S.a_ready(nxt);
            if constexpr (SP2) {
            PG8_LDB(B0, 0, 0); PG8_LDB(B1, 0, 1); PG8_SCHED; PG8_LDA(At, 0, 0); PG8_STAGE(PG8_SA(1, 1), a1 + hstepA, voffA);
            PG8_WAIT_V(8); PG8_WAIT_L(0); PG8_BAR; PG8_MMA(0, 0, At, B0); PG8_MMA(0, 1, At, B1); PG8_BAR; PG8_SCHED;
            PG8_LDA(At, 0, 1); PG8_STAGE(PG8_SB(0, 0), b2, voffB); PG8_STAGE(PG8_SB(0, 1), b2 + hstepB, voffB); PG8_STAGE(PG8_SA(0, 0), a2, voffA);
            PG8_WAIT_V(8); PG8_WAIT_L(0); PG8_BAR; PG8_MMA(1, 0, At, B0); PG8_MMA(1, 1, At, B1); PG8_BAR; PG8_SCHED;
            PG8_LDB(B0, 1, 0); PG8_LDB(B1, 1, 1); PG8_SCHED; PG8_LDA(At, 1, 0); PG8_STAGE(PG8_SA(0, 1), a2 + hstepA, voffA);
            PG8_WAIT_V(8); PG8_WAIT_L(0); PG8_BAR; PG8_MMA(0, 0, At, B0); PG8_MMA(0, 1, At, B1); PG8_BAR; PG8_SCHED;
            PG8_LDA(At, 1, 1); PG8_STAGE(PG8_SB(1, 0), b3, voffB); PG8_STAGE(PG8_SB(1, 1), b3 + hstepB, voffB); PG8_STAGE(PG8_SA(1, 0), a3, voffA);
            PG8_WAIT_V(8); PG8_WAIT_L(0); PG8_BAR; PG8_MMA(1, 0, At, B0); PG8_MMA(1, 1, At, B1); PG8_BAR; PG8_SCHED;
            } else {
            PG8_LDB(B0, 0, 0); PG8_SCHED; PG8_LDA(At, 0, 0); PG8_STAGE(PG8_SA(1, 1), a1 + hstepA, voffA);
            PG8_WAIT_L(8); PG8_BAR; PG8_WAIT_L(0); PG8_MMA(0, 0, At, B0); PG8_BAR; PG8_SCHED;
            PG8_LDB(B1, 0, 1); PG8_STAGE(PG8_SB(0, 0), b2, voffB);
            PG8_BAR; PG8_WAIT_L(0); PG8_MMA(0, 1, At, B1); PG8_BAR;
            PG8_LDA(At, 0, 1); PG8_STAGE(PG8_SA(0, 0), a2, voffA);
            PG8_BAR; PG8_WAIT_L(0); PG8_MMA(1, 0, At, B0); PG8_BAR; PG8_SCHED;
            PG8_STAGE(PG8_SB(0, 1), b2 + hstepB, voffB);
            PG8_WAIT_V(6); PG8_BAR; PG8_MMA(1, 1, At, B1); PG8_BAR;
            PG8_LDB(B0, 1, 0); PG8_SCHED; PG8_LDA(At, 1, 0); PG8_STAGE(PG8_SA(0, 1), a2 + hstepA, voffA);
            PG8_WAIT_L(8); PG8_BAR; PG8_WAIT_L(0); PG8_MMA(0, 0, At, B0); PG8_BAR; PG8_SCHED;
            PG8_LDB(B1, 1, 1); PG8_STAGE(PG8_SB(1, 0), b3, voffB);
            PG8_BAR; PG8_WAIT_L(0); PG8_MMA(0, 1, At, B1); PG8_BAR;
            PG8_LDA(At, 1, 1); PG8_STAGE(PG8_SA(1, 0), a3, voffA);
            PG8_BAR; PG8_WAIT_L(0); PG8_MMA(1, 0, At, B0); PG8_BAR; PG8_SCHED;
            PG8_STAGE(PG8_SB(1, 1), b3 + hstepB, voffB);
            PG8_WAIT_V(6); PG8_BAR; PG8_MMA(1, 1, At, B1); PG8_BAR;
            }
        }
        if constexpr (ALIGN_EPI) { if (wr == 0) PG8_BAR; }
        if constexpr (F8) asm volatile("s_nop 15\n\ts_nop 15" ::: "memory");
        if constexpr (!Epi::AFTER_DRAIN) { E(acc, cur, wr, wc, fr, fq); S.done(cur); }
        if (!has_next) break;
#pragma unroll
        for (int a = 0; a < 2; ++a)
#pragma unroll
            for (int b = 0; b < 2; ++b)
#pragma unroll
                for (int m = 0; m < 4; ++m)
#pragma unroll
                    for (int n = 0; n < 2; ++n) acc[a][b][m][n] = (f32x4){0.f, 0.f, 0.f, 0.f};
        cur = nxt; cA = nA; cB = nB; ++ui;
        if (mk && threadIdx.x == 0) mk[ui] = __builtin_amdgcn_s_memrealtime();
        if constexpr (ALIGN_EPI) { if (wr == 1) PG8_BAR; }
    }
    if (mk && threadIdx.x == 0) mk[ui + 1] = __builtin_amdgcn_s_memrealtime();
    PG8_WAIT_V(0);
    if constexpr (!ALIGN_EPI) { if (wr == 0) PG8_BAR; }
    PG8_BAR;
    if constexpr (Epi::AFTER_DRAIN) { E.fused(acc, cur, wr, wc, fr, fq, lds, wid, lane); S.done(cur); }
#undef PG8_SA
#undef PG8_SB
#undef PG8_STAGE
#undef PG8_LDA
#undef PG8_LDB
#undef PG8_MMA
#undef PG8_WAIT_V
#undef PG8_WAIT_L
#undef PG8_BAR
#undef PG8_SCHED
}
}
#include <hip/hip_bf16.h>
#include <cmath>
namespace attn_body {
using bf16=__hip_bfloat16;
using bf16x8=__attribute__((ext_vector_type(8)))short;
using s16x4=__attribute__((ext_vector_type(4)))short;
using f32x16=__attribute__((ext_vector_type(16)))float;
using u32x4=__attribute__((ext_vector_type(4)))unsigned;
constexpr int D=64;
constexpr int NW=8,QBLK=32,QB=QBLK*NW,KVBLK=64;
constexpr int ATTN_UNIT_ROWS=QB;
__device__ __forceinline__ int crow(int r,int hi){return (r&3)+8*(r>>2)+4*hi;}
#define SBAR() __builtin_amdgcn_sched_barrier(0)
__device__ __forceinline__ void cmask(f32x16&p0,f32x16&p1,int jb,int qrel,int hi){
  const float NEG=-INFINITY; int kb=64*jb+4*hi;
  #pragma unroll
  for(int r=0;r<16;++r){int kv=kb+(r&3)+8*(r>>2); if(kv>qrel)p0[r]=NEG; if(kv+32>qrel)p1[r]=NEG;}
}

constexpr int NSLOT=3, SLOTB=8192;
constexpr int LDS_K=0, LDS_V=NSLOT*SLOTB, LDS_WS=2*NSLOT*SLOTB, LDS_OST=LDS_WS+NW*64*4, LDS_BYTES=LDS_OST+NW*4096;
constexpr float C2=0.125f*1.4426950408889634f;
__device__ __forceinline__ void glds16(const void*gsrc,unsigned lds_dst){unsigned keep;
  asm volatile("s_mov_b32 %0, m0\n\ts_mov_b32 m0, %2\n\ts_nop 0\n\tglobal_load_lds_dwordx4 %1, off\n\ts_mov_b32 m0, %0":"=&s"(keep):"v"(gsrc),"s"(lds_dst):"memory");}
__device__ __forceinline__ float max3f(float a,float b,float c){float r;asm("v_max3_f32 %0, %1, %2, %3":"=v"(r):"v"(a),"v"(b),"v"(c));return r;}
__device__ __forceinline__ float max2f(float a,float b){float r;asm("v_max_f32_e32 %0, %1, %2":"=v"(r):"v"(a),"v"(b));return r;}
__device__ __forceinline__ float fadd_s(float a,float b){float r;asm("v_add_f32_e32 %0, %1, %2":"=v"(r):"v"(a),"v"(b));return r;}
__device__ __forceinline__ float fsub_s(float a,float b){float r;asm("v_sub_f32_e32 %0, %1, %2":"=v"(r):"v"(a),"v"(b));return r;}
typedef float f32x2_t __attribute__((ext_vector_type(2))); typedef __bf16 bf16x2_t __attribute__((ext_vector_type(2)));
__device__ __forceinline__ unsigned cvtpk_s(float lo,float hi){f32x2_t v={lo,hi};bf16x2_t b=__builtin_convertvector(v,bf16x2_t);return __builtin_bit_cast(unsigned,b);}
#define WAIT_BAR(N) asm volatile("s_waitcnt vmcnt(" #N ") lgkmcnt(0)\n\ts_barrier":::"memory")

__device__ __forceinline__ void qkt(f32x16&p0,f32x16&p1,const char*Kslot,const bf16x8*qr,const f32x16&negm,int r32,int hi){
  const char*kb=Kslot+hi*1024+r32*16;
  #pragma unroll
  for(int d0=0;d0<4;++d0){
    const bf16x8 b0=*reinterpret_cast<const bf16x8*>(kb+d0*2048);
    const bf16x8 b1=*reinterpret_cast<const bf16x8*>(kb+d0*2048+512);
    if(d0==0){p0=__builtin_amdgcn_mfma_f32_32x32x16_bf16(b0,qr[0],negm,0,0,0);p1=__builtin_amdgcn_mfma_f32_32x32x16_bf16(b1,qr[0],negm,0,0,0);}
    else{p0=__builtin_amdgcn_mfma_f32_32x32x16_bf16(b0,qr[d0],p0,0,0,0);p1=__builtin_amdgcn_mfma_f32_32x32x16_bf16(b1,qr[d0],p1,0,0,0);}}
}
typedef __attribute__((address_space(3))) const char* lds_cptr;
typedef short v4i16_t __attribute__((ext_vector_type(4)));
__device__ __forceinline__ void kload8(bf16x8*kf,lds_cptr kp){
  kf[0]=*(const __attribute__((address_space(3))) bf16x8*)(kp);      kf[1]=*(const __attribute__((address_space(3))) bf16x8*)(kp+512);
  kf[2]=*(const __attribute__((address_space(3))) bf16x8*)(kp+2048); kf[3]=*(const __attribute__((address_space(3))) bf16x8*)(kp+2560);
  kf[4]=*(const __attribute__((address_space(3))) bf16x8*)(kp+4096); kf[5]=*(const __attribute__((address_space(3))) bf16x8*)(kp+4608);
  kf[6]=*(const __attribute__((address_space(3))) bf16x8*)(kp+6144); kf[7]=*(const __attribute__((address_space(3))) bf16x8*)(kp+6656);
}
__device__ __forceinline__ void kload2(bf16x8*kf,lds_cptr kp,int j){ kf[2*j]=*(const __attribute__((address_space(3))) bf16x8*)(kp+j*2048); kf[2*j+1]=*(const __attribute__((address_space(3))) bf16x8*)(kp+j*2048+512); }
__device__ __forceinline__ s16x4 vtr(lds_cptr p){ return __builtin_bit_cast(s16x4,__builtin_amdgcn_ds_read_tr16_b64_v4i16((__attribute__((address_space(3))) v4i16_t*)p)); }
__device__ __forceinline__ float rowmax(const f32x16&p0,const f32x16&p1){
  float a=max3f(p0[0],p0[1],p1[0]),b=max3f(p0[2],p0[3],p1[1]);a=max3f(a,p1[2],p1[3]);
  #pragma unroll
  for(int r=4;r<16;r+=4){a=max3f(a,p0[r],p0[r+1]);b=max3f(b,p0[r+2],p0[r+3]);a=max3f(a,p1[r],p1[r+1]);b=max3f(b,p1[r+2],p1[r+3]);}
  const float m=max2f(a,b);
  auto rr=__builtin_amdgcn_permlane32_swap(__float_as_uint(m),__float_as_uint(m),false,false);
  return max2f(__uint_as_float(rr[0]),__uint_as_float(rr[1]));
}
__device__ __forceinline__ void pv(f32x16*o,int vb,bf16x8 pa0,bf16x8 pa1,bf16x8 pa2,bf16x8 pa3){
  #pragma unroll
  for(int d0=0;d0<2;++d0){s16x4 lo[4],hi[4];
    #pragma unroll
    for(int ks=0;ks<4;++ks){
      asm volatile("ds_read_b64_tr_b16 %0,%1 offset:%c2":"=&v"(lo[ks]):"v"(vb),"i"(d0*4096+ks*1024):"memory");
      asm volatile("ds_read_b64_tr_b16 %0,%1 offset:%c2":"=&v"(hi[ks]):"v"(vb),"i"(d0*4096+ks*1024+512):"memory");}
    asm volatile("s_waitcnt lgkmcnt(0)":::"memory");SBAR();
    #define PK(k) (bf16x8){lo[k][0],lo[k][1],lo[k][2],lo[k][3],hi[k][0],hi[k][1],hi[k][2],hi[k][3]}
    o[d0]=__builtin_amdgcn_mfma_f32_32x32x16_bf16(pa0,PK(0),o[d0],0,0,0);
    o[d0]=__builtin_amdgcn_mfma_f32_32x32x16_bf16(pa1,PK(1),o[d0],0,0,0);
    o[d0]=__builtin_amdgcn_mfma_f32_32x32x16_bf16(pa2,PK(2),o[d0],0,0,0);
    o[d0]=__builtin_amdgcn_mfma_f32_32x32x16_bf16(pa3,PK(3),o[d0],0,0,0);
    #undef PK
  }
}

#ifndef ATTN_STORE16
#define ATTN_STORE16(p,v) (*(u32x4*)(p)=(v))
#endif
template<int THRL,bool CAUSAL,bool FOX,int PQ,int PK> __device__ __forceinline__ void attn_unit(long qrow,long kvrow,int NT,const bf16*Q,const bf16*__restrict__ K,const bf16*__restrict__ V,bf16*O,const float*cs,char*shm){
  const int tid=threadIdx.x,lane=tid&63,r32=lane&31,hi=lane>>5; const int wid=__builtin_amdgcn_readfirstlane(tid>>6);
  const bf16*Qw=Q+(qrow+wid*QBLK)*PQ;
  const bf16*Kh=K+kvrow*PK,*Vh=V+kvrow*PK;
  const unsigned lds0=(unsigned)(uintptr_t)shm;
  float*wsf=(float*)(shm+LDS_WS)+wid*64;
  const bf16*ksrc=Kh+(long)lane*PK+wid*8;
  const bf16*vsrc=Vh+(long)(16*(wid&3)+(lane>>2))*PK+(wid>>2)*32+(lane&3)*8;
  const unsigned kdst=lds0+LDS_K+wid*1024, vdst=lds0+LDS_V+wid*1024;
  #define DMA_K(t,slot) glds16(ksrc+(long)(t)*KVBLK*PK,(unsigned)__builtin_amdgcn_readfirstlane(kdst+(slot)))
  #define DMA_V(t,slot) glds16(vsrc+(long)(t)*KVBLK*PK,(unsigned)__builtin_amdgcn_readfirstlane(vdst+(slot)))
  const int vb0=(int)(lds0+LDS_V)+((lane>>4)&1)*32+(lane&3)*8+(4*hi+((lane&15)>>2))*64;
  const char*Kbase=shm+LDS_K; bf16x8 kf[8];
  const lds_cptr shm3=(lds_cptr)shm; const lds_cptr kp0=shm3+LDS_K+hi*1024+r32*16; const lds_cptr vp0=shm3+LDS_V+((lane>>4)&1)*32+(lane&3)*8+(4*hi+((lane&15)>>2))*64;
  typedef __attribute__((address_space(3))) float lds_f32; typedef float f32x4_t __attribute__((ext_vector_type(4)));
  const __attribute__((address_space(3))) f32x4_t* csl=(const __attribute__((address_space(3))) f32x4_t*)(shm3+LDS_BYTES);
  if(FOX){ __attribute__((address_space(3))) f32x4_t* d=(__attribute__((address_space(3))) f32x4_t*)(shm3+LDS_BYTES); const f32x4_t* s=(const f32x4_t*)cs; for(int i=tid;i<NT*16;i+=NW*64)d[i]=s[i]; }
  #define CINIT(P0,P1,t) do{ if(FOX){ const __attribute__((address_space(3))) f32x4_t* cp_=csl+16*(t)+hi; const float nm_=-mhat; \
    _Pragma("unroll") for(int j_=0;j_<4;++j_){ const f32x4_t a_=cp_[2*j_], b_=cp_[8+2*j_]; \
      P0[4*j_]=nm_-a_[0];P0[4*j_+1]=nm_-a_[1];P0[4*j_+2]=nm_-a_[2];P0[4*j_+3]=nm_-a_[3]; P1[4*j_]=nm_-b_[0];P1[4*j_+1]=nm_-b_[1];P1[4*j_+2]=nm_-b_[2];P1[4*j_+3]=nm_-b_[3]; } } }while(0)
  #define FBIAS(P0,P1,t) do{ if(FOX){ const __attribute__((address_space(3))) f32x4_t* cp_=csl+16*(t)+hi; \
    _Pragma("unroll") for(int j_=0;j_<4;++j_){ const f32x4_t a_=cp_[2*j_], b_=cp_[8+2*j_]; \
      P0[4*j_]-=a_[0];P0[4*j_+1]-=a_[1];P0[4*j_+2]-=a_[2];P0[4*j_+3]-=a_[3]; P1[4*j_]-=b_[0];P1[4*j_+1]-=b_[1];P1[4*j_+2]-=b_[2];P1[4*j_+3]-=b_[3]; } } }while(0)
  DMA_K(0,0);DMA_V(0,0);DMA_K(1,SLOTB);
  bf16x8 qr[4];
  #pragma unroll
  for(int d0=0;d0<4;++d0)qr[d0]=*reinterpret_cast<const bf16x8*>(&Qw[(long)r32*PQ+d0*16+hi*8]);
  float mhat=0.f,l_reg=0.f;f32x16 o[2];o[0]=f32x16{};o[1]=f32x16{};f32x16 negm=f32x16{};asm volatile("":"+v"(negm));
  const int qrel=wid*QBLK+r32;
  #define CMASK(P0,P1,t) do{ if(CAUSAL){int jb_=(t)-(NT-4); if(jb_>=0)cmask(P0,P1,jb_,qrel,hi);} }while(0)
  bool resc=false;
  #define START(P0,P1) do{ const float rm=rowmax(P0,P1); resc=false; \
    { const float dl=rm; mhat=fadd_s(mhat,dl); \
      _Pragma("unroll") for(int r=0;r<16;++r){P0[r]=fsub_s(P0[r],dl);P1[r]=fsub_s(P1[r],dl);} \
      _Pragma("unroll") for(int r=0;r<16;++r)negm[r]=-mhat; asm volatile("":"+v"(negm)); } \
    _Pragma("unroll") for(int r=0;r<16;++r)P0[r]=__builtin_amdgcn_exp2f(P0[r]); }while(0)
  #define RESC() do{ if(resc){ asm volatile("s_waitcnt lgkmcnt(0)":::"memory"); \
      _Pragma("unroll") for(int d_=0;d_<2;++d_) _Pragma("unroll") for(int r=0;r<16;++r)o[d_][r]*=wsf[crow(r,hi)]; } }while(0)
  f32x16 pA0,pA1,pB0,pB1;
  int sl_prev=0,sl_cur=0,sl_next=SLOTB;
  #define ROT() do{sl_prev=sl_cur;sl_cur=sl_next;sl_next=(sl_next==(NSLOT-1)*SLOTB)?0:sl_next+SLOTB;}while(0)
  DMA_K(2,2*SLOTB);
  WAIT_BAR(3);
  qkt(pA0,pA1,Kbase,qr,negm,r32,hi);asm volatile("s_nop 15\n\ts_nop 7":"+v"(pA0),"+v"(pA1));FBIAS(pA0,pA1,0);CMASK(pA0,pA1,0);
  START(pA0,pA1);
  _Pragma("unroll") for(int r=0;r<16;++r)pA1[r]=__builtin_amdgcn_exp2f(pA1[r]);
  WAIT_BAR(0);
  DMA_K(3,0);DMA_V(1,SLOTB);
  ROT();
  kload8(kf,kp0+sl_cur);
  WAIT_BAR(2);
  s16x4 vlo[8],vhi[8]; u32x4 pw0,pw1,pw2,pw3;
  #define PKW(P,B) cvtpk_s(P[B],P[B+1])
  #define PAF(k) __builtin_bit_cast(bf16x8,pw##k)
  #define VFR(i) (bf16x8){vlo[i][0],vlo[i][1],vlo[i][2],vlo[i][3],vhi[i][0],vhi[i][1],vhi[i][2],vhi[i][3]}
  #define PIN(x) asm volatile("":"+v"(x))
  #define MX3(a,b,c) __builtin_fmaxf(__builtin_fmaxf((a),(b)),(c))
  #define GAPA(MF,A0,A1,A2,A3,W0,W1,PW) do{ MF; sacc+=A0; sacc+=A1; sacc+=A2; sacc+=A3; PIN(sacc); W0; W1; PIN(PW); SBAR(); }while(0)
  #define EX(v) __builtin_amdgcn_exp2f(v)
  #define GAPB(MF,X,B) do{ MF; X[B]=EX(X[B]); X[B+1]=EX(X[B+1]); X[B+2]=EX(X[B+2]); X[B+3]=EX(X[B+3]); PIN(X); SBAR(); }while(0)
  #define VRD(i) do{ vlo[i]=vtr(vp_+(((i)>>2)*4096+((i)&3)*1024)); vhi[i]=vtr(vp_+(((i)>>2)*4096+((i)&3)*1024+512)); }while(0)
  #define KRD(G,j) do{ if(G){ kload2(kf,kp0+sl_next,j); SBAR(); } }while(0)
  #define STEP(C0,C1,P0,P1,t,GK,GV,GL) do{ SBAR(); CINIT(C0,C1,t); SBAR(); \
    const lds_cptr vp_=vp0+sl_prev; \
    VRD(0); SBAR(); float sacc=(P0[0]+P0[1]); \
    GAPA(C0=__builtin_amdgcn_mfma_f32_32x32x16_bf16(kf[0],qr[0],(FOX?C0:negm),0,0,0), P0[2],P0[3],P0[4],P0[5],     pw0[0]=PKW(P0,0), pw0[1]=PKW(P0,2), pw0); \
    VRD(4); SBAR(); GAPA(C1=__builtin_amdgcn_mfma_f32_32x32x16_bf16(kf[1],qr[0],(FOX?C1:negm),0,0,0), P0[6],P0[7],P0[8],P0[9],     pw0[2]=PKW(P0,4), pw0[3]=PKW(P0,6), pw0); \
    VRD(1); SBAR(); GAPA(C0=__builtin_amdgcn_mfma_f32_32x32x16_bf16(kf[2],qr[1],C0,0,0,0),   P0[10],P0[11],P0[12],P0[13], pw1[0]=PKW(P0,8), pw1[1]=PKW(P0,10), pw1); \
    VRD(5); SBAR(); GAPA(C1=__builtin_amdgcn_mfma_f32_32x32x16_bf16(kf[3],qr[1],C1,0,0,0),   P0[14],P0[15],P1[0],P1[1],   pw1[2]=PKW(P0,12),pw1[3]=PKW(P0,14), pw1); \
    VRD(2); SBAR(); GAPA(C0=__builtin_amdgcn_mfma_f32_32x32x16_bf16(kf[4],qr[2],C0,0,0,0),   P1[2],P1[3],P1[4],P1[5],     pw2[0]=PKW(P1,0), pw2[1]=PKW(P1,2), pw2); \
    VRD(6); SBAR(); GAPA(C1=__builtin_amdgcn_mfma_f32_32x32x16_bf16(kf[5],qr[2],C1,0,0,0),   P1[6],P1[7],P1[8],P1[9],     pw2[2]=PKW(P1,4), pw2[3]=PKW(P1,6), pw2); \
    VRD(3); SBAR(); GAPA(C0=__builtin_amdgcn_mfma_f32_32x32x16_bf16(kf[6],qr[3],C0,0,0,0),   P1[10],P1[11],P1[12],P1[13], pw3[0]=PKW(P1,8), pw3[1]=PKW(P1,10), pw3); \
    VRD(7); SBAR(); GAPA(C1=__builtin_amdgcn_mfma_f32_32x32x16_bf16(kf[7],qr[3],C1,0,0,0),   P1[14],P1[15],0.f,0.f,       pw3[2]=PKW(P1,12),pw3[3]=PKW(P1,14), pw3); \
    l_reg+=sacc; \
    if(GK){DMA_K((t)+3,sl_cur);} if(GV){DMA_V((t)+1,sl_next);} \
    CMASK(C0,C1,t); \
    { float a=MX3(C0[0],C0[1],C1[0]),b=MX3(C0[2],C0[3],C1[1]); a=MX3(a,C1[2],C1[3]); \
      _Pragma("unroll") for(int r=4;r<16;r+=4){a=MX3(a,C0[r],C0[r+1]);b=MX3(b,C0[r+2],C0[r+3]);a=MX3(a,C1[r],C1[r+1]);b=MX3(b,C1[r+2],C1[r+3]);} \
      float rm=__builtin_fmaxf(a,b); { auto rr=__builtin_amdgcn_permlane32_swap(__float_as_uint(rm),__float_as_uint(rm),false,false); rm=__builtin_fmaxf(__uint_as_float(rr[0]),__uint_as_float(rr[1])); } \
      resc=false; \
      if(__builtin_expect(__any(rm>(float)THRL),0)){ const float dl=__builtin_fmaxf(rm,0.f); mhat+=dl; \
        _Pragma("unroll") for(int r=0;r<16;++r){C0[r]-=dl;C1[r]-=dl;} \
        _Pragma("unroll") for(int r=0;r<16;++r)negm[r]=-mhat; asm volatile("":"+v"(negm)); \
        const float f=__builtin_amdgcn_exp2f(-dl); l_reg*=f; if(hi==0)wsf[r32]=f; resc=true; } } \
    SBAR(); \
    GAPB(o[0]=__builtin_amdgcn_mfma_f32_32x32x16_bf16(PAF(0),VFR(0),o[0],0,0,0), C0,0); \
    GAPB(o[1]=__builtin_amdgcn_mfma_f32_32x32x16_bf16(PAF(0),VFR(4),o[1],0,0,0), C0,4); \
    KRD(GL,0); GAPB(o[0]=__builtin_amdgcn_mfma_f32_32x32x16_bf16(PAF(1),VFR(1),o[0],0,0,0), C0,8); \
    KRD(GL,1); GAPB(o[1]=__builtin_amdgcn_mfma_f32_32x32x16_bf16(PAF(1),VFR(5),o[1],0,0,0), C0,12); \
    KRD(GL,2); GAPB(o[0]=__builtin_amdgcn_mfma_f32_32x32x16_bf16(PAF(2),VFR(2),o[0],0,0,0), C1,0); \
    KRD(GL,3); GAPB(o[1]=__builtin_amdgcn_mfma_f32_32x32x16_bf16(PAF(2),VFR(6),o[1],0,0,0), C1,4); \
    GAPB(o[0]=__builtin_amdgcn_mfma_f32_32x32x16_bf16(PAF(3),VFR(3),o[0],0,0,0), C1,8); \
    GAPB(o[1]=__builtin_amdgcn_mfma_f32_32x32x16_bf16(PAF(3),VFR(7),o[1],0,0,0), C1,12); \
    }while(0)
  int t=1;
  #undef CMASK
  #define CMASK(P0,P1,t) do{}while(0)
  for(;t+5<NT;t+=2){
    STEP(pB0,pB1,pA0,pA1,t,true,true,true);     WAIT_BAR(2); RESC(); ROT();
    STEP(pA0,pA1,pB0,pB1,t+1,true,true,true);   WAIT_BAR(2); RESC(); ROT();
  }
  #undef CMASK
  #define CMASK(P0,P1,t) do{ if(CAUSAL){int jb_=(t)-(NT-4); if(jb_>=0)cmask(P0,P1,jb_,qrel,hi);} }while(0)
  #define ENDW(tt) do{ if((tt)+3<NT){WAIT_BAR(2);} else if((tt)+2<NT){WAIT_BAR(1);} else {WAIT_BAR(0);} }while(0)
  for(;t+1<NT;t+=2){
    STEP(pB0,pB1,pA0,pA1,t,(t+3<NT),(t+1<NT),(t+1<NT));       ENDW(t);   RESC(); ROT();
    STEP(pA0,pA1,pB0,pB1,t+1,(t+4<NT),(t+2<NT),(t+2<NT));     ENDW(t+1); RESC(); ROT();
  }
  STEP(pB0,pB1,pA0,pA1,NT-1,false,false,false); RESC();
  { float sacc=pB0[0]+pB0[1]; _Pragma("unroll") for(int r=2;r<16;++r)sacc+=pB0[r]; _Pragma("unroll") for(int r=0;r<16;++r)sacc+=pB1[r]; l_reg+=sacc;
    pw0=(u32x4){PKW(pB0,0),PKW(pB0,2),PKW(pB0,4),PKW(pB0,6)};pw1=(u32x4){PKW(pB0,8),PKW(pB0,10),PKW(pB0,12),PKW(pB0,14)};pw2=(u32x4){PKW(pB1,0),PKW(pB1,2),PKW(pB1,4),PKW(pB1,6)};pw3=(u32x4){PKW(pB1,8),PKW(pB1,10),PKW(pB1,12),PKW(pB1,14)};
    SBAR(); pv(o,vb0+sl_cur,PAF(0),PAF(1),PAF(2),PAF(3)); }
  #undef PKW
  #undef PAF
  #undef VFR
  #undef PIN
  #undef MX3
  #undef GAPA
  #undef GAPB
  #undef EX
  #undef VRD
  #undef KRD
  #undef STEP
  #undef ENDW
  {auto rr=__builtin_amdgcn_permlane32_swap(__float_as_uint(l_reg),__float_as_uint(l_reg),false,false);l_reg=__uint_as_float(rr[0])+__uint_as_float(rr[1]);}
  if(hi==0)wsf[32+r32]=l_reg;asm volatile("s_waitcnt lgkmcnt(0)":::"memory");
  float rli[16];
  #pragma unroll
  for(int r=0;r<16;++r)rli[r]=__builtin_amdgcn_rcpf(wsf[32+crow(r,hi)]);
  bf16*Ow=O+(qrow+wid*QBLK)*PQ;
  { bf16*stg=(bf16*)(shm+LDS_OST)+wid*2048;
    #pragma unroll
    for(int r=0;r<16;++r){const int orow=crow(r,hi);
      #pragma unroll
      for(int d0=0;d0<2;++d0)stg[orow*64+d0*32+r32]=__float2bfloat16(o[d0][r]*rli[r]);}
    asm volatile("s_waitcnt lgkmcnt(0)":::"memory");
    #pragma unroll
    for(int i=0;i<4;++i){const int row=i*8+(lane>>3),ch=lane&7; const u32x4 v=*(const u32x4*)(stg+row*64+ch*8); ATTN_STORE16(Ow+(long)row*PQ+ch*8,v);} }
  asm volatile("s_waitcnt lgkmcnt(0)\n\ts_barrier":::"memory");
  #undef DMA_K
  #undef DMA_V
  #undef CMASK
  #undef FBIAS
  #undef CINIT
  #undef START
  #undef RESC
  #undef ROT
}
constexpr int ATTN_LDS_BYTES=LDS_BYTES;
#undef SBAR
#undef WAIT_BAR
}
#define GAS __attribute__((address_space(1)))
#define LAS __attribute__((address_space(3)))
typedef unsigned short bf16;
typedef unsigned v4u __attribute__((ext_vector_type(4)));
typedef float f32x4 __attribute__((ext_vector_type(4)));
typedef short bf16x8 __attribute__((ext_vector_type(8)));
typedef GAS unsigned gu32;
typedef GAS unsigned long long gu64;
#define RLX_AGENT __ATOMIC_RELAXED, __HIP_MEMORY_SCOPE_AGENT
#define LDS_WAIT() asm volatile("s_waitcnt lgkmcnt(0)" ::: "memory")
#define VM_WAIT() asm volatile("s_waitcnt vmcnt(0)" ::: "memory")
__device__ __forceinline__ unsigned long long rt() { return __builtin_amdgcn_s_memrealtime(); }
__device__ __forceinline__ unsigned f2bf(float f) { unsigned u = __builtin_bit_cast(unsigned, f); return (u + 0x7fffu + ((u >> 16) & 1u)) >> 16; }
__device__ __forceinline__ unsigned pk2(float lo, float hi) { return f2bf(lo) | (f2bf(hi) << 16); }

#define XB_TMO      128
#define XB_XCNT(j)  (256  + 64 * (j))
#define XB_XSUB(j)  (1280 + 64 * (j))
#define XB_XGEN(j)  (2304 + 64 * (j))
#define XB_TOP      3328
#define XB_TOPGEN   3392
#define XCD_BAR_WORDS 3456
#define XB_SPIN_CAP (1u << 18)

__device__ __forceinline__ unsigned xb_ld(unsigned* p)              { return __hip_atomic_load(p, __ATOMIC_RELAXED, __HIP_MEMORY_SCOPE_AGENT); }
__device__ __forceinline__ unsigned xb_add(unsigned* p, unsigned v) { return __hip_atomic_fetch_add(p, v, __ATOMIC_RELAXED, __HIP_MEMORY_SCOPE_AGENT); }
__device__ __forceinline__ unsigned xb_xcc_id() { return (unsigned)__builtin_amdgcn_s_getreg((3 << 11) | 20) & 0xFu; }
#define XB_SPIN(cond, bar) do { unsigned _sp = 0; while (cond) { __builtin_amdgcn_s_sleep(1); \
    if ((++_sp & 255u) == 0u) { if (xb_ld(&(bar)[XB_TMO])) break; if (_sp > XB_SPIN_CAP) { atomicAdd(&(bar)[XB_TMO], 1u); break; } } } } while (0)

struct XcdBarrier {
    unsigned* bar; unsigned x;
    volatile LAS unsigned* st;
};

__device__ __forceinline__ XcdBarrier xcd_barrier_post(unsigned* bar, volatile LAS unsigned* st) {
    XcdBarrier b; b.bar = bar; b.x = xb_xcc_id(); b.st = st;
    if (threadIdx.x == 0) (void)xb_add(&bar[XB_XCNT(b.x)], 1u);
    return b;
}
__device__ __forceinline__ void xcd_barrier_complete(unsigned* bar, unsigned x, unsigned& nloc, unsigned& nx) {
    const unsigned G = gridDim.x * gridDim.y * gridDim.z;
    unsigned sum, cnt, mine, sp = 0u;
    for (;;) {
        sum = 0u; cnt = 0u; mine = 0u;
#pragma unroll
        for (unsigned j = 0; j < 16; ++j) { const unsigned c = xb_ld(&bar[XB_XCNT(j)]); sum += c; cnt += (c > 0u) ? 1u : 0u; mine = (j == x) ? c : mine; }
        if (sum == G) break;
        __builtin_amdgcn_s_sleep(1);
        if ((++sp & 255u) == 0u) { if (xb_ld(&bar[XB_TMO])) break; if (sp > XB_SPIN_CAP) { atomicAdd(&bar[XB_TMO], 1u); break; } }
    }
    nloc = mine > 0u ? mine : 1u; nx = cnt > 0u ? cnt : 1u;
}

__device__ __forceinline__ void xcd_barrier(const XcdBarrier& b) {
    asm volatile("s_waitcnt vmcnt(0)" ::: "memory");
    __syncthreads();
    if (threadIdx.x == 0) {
        unsigned* bar = b.bar;
        __builtin_amdgcn_s_waitcnt(0);
        unsigned nloc = b.st[0], nx = b.st[1];
        if (nloc == 0u) { xcd_barrier_complete(bar, b.x, nloc, nx); b.st[0] = nloc; b.st[1] = nx; }
        const unsigned old = xb_add(&bar[XB_XSUB(b.x)], 1u);
        const unsigned gen = old / nloc;
        if (old + 1u == (gen + 1u) * nloc) {
            __builtin_amdgcn_fence(__ATOMIC_RELEASE, "agent");
            asm volatile("s_waitcnt vmcnt(0)" ::: "memory");
            const unsigned og = xb_add(&bar[XB_TOP], 1u);
            const unsigned tg = og / nx;
            if (og + 1u == (tg + 1u) * nx) xb_add(&bar[XB_TOPGEN], 1u);
            else XB_SPIN(xb_ld(&bar[XB_TOPGEN]) == tg, bar);
            __builtin_amdgcn_fence(__ATOMIC_ACQUIRE, "agent");
            xb_add(&bar[XB_XGEN(b.x)], 1u);
            asm volatile("s_waitcnt vmcnt(0)" ::: "memory");
        } else {
            XB_SPIN(xb_ld(&bar[XB_XGEN(b.x)]) == gen, bar);
            __builtin_amdgcn_fence(__ATOMIC_ACQUIRE, "agent");
            asm volatile("s_waitcnt vmcnt(0)" ::: "memory");
        }
    }
    __syncthreads();
}
constexpr int NWAVES = 8, NTHR = 512;
constexpr int NB = 4, SEQ = 8192, D = 1024, T = NB * SEQ;
constexpr int NMEM = 256, TM = NB * NMEM;
constexpr int LDY = 2816, FF = 2816, NEXP = 8;
constexpr int Y_Q = 0, Y_K = 384, Y_V = 768, Y_R = 1536, Y_MQ = 2304, Y_X = 2560;
constexpr int Z_K = 0, Z_V = 768, Z_Q = 1536;
constexpr int MIX_OFF = 1536;
constexpr float EPS = 1e-6f;
constexpr float LOG2E = 1.4426950408889634f;
constexpr float C2 = 0.125f * LOG2E;
constexpr int MOE_ROWS = T + NEXP * 256;
constexpr int MOE_TILES = MOE_ROWS / 256;
constexpr int WDP = 2816;
constexpr float F8_SA = 8.f, F8_SW = 256.f, F8_SH = 4.f;

constexpr size_t MiB = 1u << 20;
constexpr size_t WS_CTL = 0, CTL_ZERO_BYTES = 1 * MiB;
constexpr size_t WS_CS = 1 * MiB;
constexpr size_t WS_SIDE = 3 * MiB;
constexpr size_t WS_EID = 5 * MiB;
constexpr size_t WS_GW = WS_EID + 128 * 1024;
constexpr size_t WS_RSTD = WS_GW + 256 * 1024;
constexpr size_t WS_POS = 5 * MiB + 512 * 1024;
constexpr size_t WS_TOK = 6 * MiB;
constexpr size_t WS_GATE = WS_TOK + 512 * 1024;
constexpr size_t WS_TILEE = 7 * MiB;
constexpr size_t WS_KT = 7 * MiB + 256 * 1024;
constexpr size_t WS_DD = 7 * MiB + 64 * 1024;
constexpr size_t WS_MKV = 8 * MiB;
constexpr size_t WS_XM = 10 * MiB;
constexpr size_t WS_W = 16 * MiB;
constexpr size_t WS_WA = WS_W, WS_WB = WS_WA + 5632 * 1024, WS_WMKV = WS_WB + 5632 * 1024, WS_WO0 = WS_WMKV + 2 * MiB, WS_WO1 = WS_WO0 + 2 * MiB;
constexpr size_t WS_WGU0 = WS_WO1 + 2 * MiB, WS_WD0 = WS_WGU0 + 11 * MiB, WS_WGUM = WS_WD0 + 5632 * 1024, WS_WDM = WS_WGUM + 88 * MiB, WS_WEND = WS_WDM + 44 * MiB;
constexpr size_t WS_Y = 184 * MiB;
constexpr size_t WS_X = 371 * MiB;
constexpr size_t WS_DS = WS_X + 64 * MiB;
constexpr size_t WS_END = WS_X + 2 * (size_t)MOE_ROWS * D * 2;
static_assert(F8_SA * F8_SW == 2048.f && F8_SH * F8_SW == 1024.f, "the F8SHIFT template arguments of the fp8 GEMM phases");
static_assert(WS_WEND <= WS_Y && WS_Y + (size_t)MOE_ROWS * FF * 2 <= WS_X && WS_END <= 512 * MiB && WS_DS + 256ull * 96 * 192 * 4 <= WS_END, "d_ws map");
constexpr int CW_BAR = 4096;
constexpr size_t WS_SS1 = 12 * MiB, WS_SS2 = 14 * MiB;
constexpr int CW_Q = 20480;
#ifndef FOX_SKIP_V
#define FOX_SKIP_V 32.f
#endif
constexpr float FOX_SKIP = FOX_SKIP_V;
constexpr int CW_CNT = 16384;
constexpr int RING_OFF = 0, RING_BYTES = 157696;
constexpr int LDSCTL_OFF = RING_BYTES, MISC_OFF = LDSCTL_OFF + 320;
constexpr int LDS_BYTES = 158720;
static_assert(MISC_OFF + 128 <= LDS_BYTES, "LDS map");

__device__ __forceinline__ float bf2f(unsigned short v) { return __uint_as_float((unsigned)v << 16); }
__device__ __forceinline__ float wave_sum(float v) {
#pragma unroll
    for (int o = 1; o < 64; o <<= 1) v += __shfl_xor(v, o);
    return v;
}
__device__ __forceinline__ void cvt_item(const float* W, int ldw, int col0, int ncr, bf16* WT, int ldt, int drow, const float* gain, float scale, LAS float* scr, int k0, int n0, int lane) {
    const int n = lane & 31; const bool ok = (n0 + n) < ncr;
    float vv[32];
#pragma unroll
    for (int i = 0; i < 32; ++i) { const int kk = 2 * i + (lane >> 5); vv[i] = ok ? __builtin_nontemporal_load(W + (size_t)(k0 + kk) * ldw + col0 + n0 + n) : 0.f; }
#pragma unroll
    for (int i = 0; i < 32; ++i) { const int kk = 2 * i + (lane >> 5); float v = vv[i] * scale; if (gain) v *= gain[k0 + kk]; scr[kk * 33 + n] = v; }
    LDS_WAIT(); asm volatile("" ::: "memory");
    const int c = lane & 7;
#pragma unroll
    for (int j = 0; j < 4; ++j) { const int nn = (lane >> 3) + 8 * j; const LAS float* s = scr + (8 * c) * 33 + nn;
        v4u o; o.x = pk2(s[0 * 33], s[1 * 33]); o.y = pk2(s[2 * 33], s[3 * 33]); o.z = pk2(s[4 * 33], s[5 * 33]); o.w = pk2(s[6 * 33], s[7 * 33]);
        *(GAS v4u*)(WT + (size_t)(drow + nn) * ldt + k0 + 8 * c) = o; }
    LDS_WAIT(); asm volatile("" ::: "memory");
}
__device__ __forceinline__ void cvt8_load(float (&vv)[32], const float* W, int ldw, int k0, int n0, int lane, int col0 = 0, int ncr = 1 << 30) {
    const int n = lane & 31; const bool ok = (n0 + n) < ncr;
#pragma unroll
    for (int i = 0; i < 32; ++i) { const int kk = 2 * i + (lane >> 5); vv[i] = ok ? __builtin_nontemporal_load(W + (size_t)(k0 + kk) * ldw + col0 + n0 + n) : 0.f; }
}
__device__ __forceinline__ void cvt8_finish(const float (&vv)[32], unsigned char* WT, int ldt, int drow, const float* gain, float scale, LAS float* scr, int k0, int lane) {
    const int n = lane & 31;
#pragma unroll
    for (int i = 0; i < 32; ++i) { const int kk = 2 * i + (lane >> 5); float v = vv[i] * scale; if (gain) v *= gain[k0 + kk]; scr[kk * 33 + n] = v; }
    LDS_WAIT(); asm volatile("" ::: "memory");
    const int c = lane & 7;
#pragma unroll
    for (int j = 0; j < 4; ++j) { const int nn = (lane >> 3) + 8 * j; const LAS float* s = scr + (8 * c) * 33 + nn;
        typedef unsigned u32x2 __attribute__((ext_vector_type(2))); u32x2 o;
        o.x = pg8::pack_fp8x4(s[0 * 33], s[1 * 33], s[2 * 33], s[3 * 33]); o.y = pg8::pack_fp8x4(s[4 * 33], s[5 * 33], s[6 * 33], s[7 * 33]);
        *(GAS u32x2*)(WT + (size_t)(drow + nn) * ldt + k0 + 8 * c) = o; }
    LDS_WAIT(); asm volatile("" ::: "memory");
}
__device__ __forceinline__ void cvt8_load4(f32x4 (&vv)[8], const float* W, int ldw, int k0, int n0, int lane) {
    const GAS float* p = (const GAS float*)(W + (size_t)(k0 + 8 * (lane >> 3)) * ldw + n0 + 4 * (lane & 7));
#pragma unroll
    for (int i = 0; i < 8; ++i) vv[i] = __builtin_nontemporal_load((const GAS f32x4*)(p + (size_t)i * ldw));
}
__device__ __forceinline__ void cvt8_finish4(const f32x4 (&vv)[8], unsigned char* WT, int ldt, int drow, const LAS float* gain, float scale, int k0, int lane) {
    const int l3 = lane >> 3, l7 = lane & 7;
    f32x4 g0 = {scale, scale, scale, scale}, g1 = g0;
    if (gain) { g0 = *(const LAS f32x4*)(gain + k0 + 8 * l3) * scale; g1 = *(const LAS f32x4*)(gain + k0 + 8 * l3 + 4) * scale; }
    typedef unsigned u32x2 __attribute__((ext_vector_type(2)));
    unsigned char* o8 = WT + (size_t)(drow + 4 * l7) * ldt + k0 + 8 * l3;
#pragma unroll
    for (int j = 0; j < 4; ++j) { u32x2 o;
        o.x = pg8::pack_fp8x4(vv[0][j] * g0.x, vv[1][j] * g0.y, vv[2][j] * g0.z, vv[3][j] * g0.w); o.y = pg8::pack_fp8x4(vv[4][j] * g1.x, vv[5][j] * g1.y, vv[6][j] * g1.z, vv[7][j] * g1.w);
        *(GAS u32x2*)(o8 + (size_t)j * ldt) = o; }
}
__device__ __forceinline__ void cvt_item8(const float* W, int ldw, unsigned char* WT, int ldt, int drow, const float* gain, float scale, LAS float* scr, int k0, int n0, int lane, int col0 = 0, int ncr = 1 << 30) {
    float vv[32]; cvt8_load(vv, W, ldw, k0, n0, lane, col0, ncr); cvt8_finish(vv, WT, ldt, drow, gain, scale, scr, k0, lane);
}
__device__ __forceinline__ float rms_row_to_bf16(const float* xrow, bf16* orow, int lane) {
    const GAS f32x4* xr = (const GAS f32x4*)xrow + lane;
    f32x4 v[4]; float s = 0.f;
#pragma unroll
    for (int j = 0; j < 4; ++j) { v[j] = __builtin_nontemporal_load(xr + 64 * j); s += (v[j].x * v[j].x + v[j].y * v[j].y) + (v[j].z * v[j].z + v[j].w * v[j].w); }
    const float rstd = 1.0f / sqrtf(wave_sum(s) * (1.f / D) + EPS);
    GAS unsigned long long* o8 = (GAS unsigned long long*)orow + lane;
#pragma unroll
    for (int j = 0; j < 4; ++j) o8[64 * j] = (unsigned long long)pk2(v[j].x * rstd, v[j].y * rstd) | ((unsigned long long)pk2(v[j].z * rstd, v[j].w * rstd) << 32);
    return rstd;
}

#ifndef CONV_DIV
#define CONV_DIV 4
#endif
#ifndef CONV_F
#define CONV_F 16
#endif
struct Args { const float* in[23]; float* out; unsigned char* ws; int ph_lo, ph_hi; };

constexpr int CV_KB = D / 64;
constexpr int CV_A = CV_KB * (2592 / 32), CV_MKV = 2 * CV_KB * 16, CV_B = CV_KB * (2592 / 32), CV_O = 2 * CV_KB * 32, CV_GU = 2 * CV_KB * 88, CV_D = 44 * 32;
constexpr int CV_MG = NEXP * CV_KB * 88, CV_MD = NEXP * 44 * 32;
constexpr int CV_P1 = CV_A + CV_MKV, CV_DENSE = CV_P1 + CV_B + CV_O + CV_GU + CV_D, CV_ALL = CV_DENSE + 2 * CV_MG + CV_MD;
static_assert((2 * CV_MG + CV_MD) % 64 == 0, "expert items come in super-items of 64");
__device__ __forceinline__ void cvt_one(const Args& A, LAS float* scr, int lane, int it) {
    unsigned char* ws = A.ws; constexpr int KB = CV_KB;
    const float* nmix = A.in[2]; const float* nmem = A.in[3]; const float* nffn = A.in[4]; const float* nkv = A.in[5];
    int r = it;
    if (r < CV_A) { const int kb = r / 81, nb = r % 81, n0 = nb * 32, k0 = kb * 64;
        int col0, nloc, ncr = 1 << 30; float sc = 1.f;
        if (n0 < 384) { col0 = 0; nloc = n0; sc = 0.10206207261596575f  ; } else if (n0 < 2304) { col0 = 0; nloc = n0; } else if (n0 < 2560) { col0 = 2320; nloc = n0 - 2304; sc = C2; } else { col0 = 2304; nloc = 0; ncr = 16; }
        cvt_item(A.in[7], 2576, col0, ncr, (bf16*)(ws + WS_WA), D, n0, nmix, sc, scr, k0, nloc, lane); return; } r -= CV_A;
    if (r < CV_MKV) { const int l = r / (KB * 16), rr = r % (KB * 16), kb = rr / 16, nb = rr % 16;
        cvt_item(A.in[14] + (size_t)l * D * 512, 512, 0, 1 << 30, (bf16*)(ws + WS_WMKV), D, 512 * l + nb * 32, nmem + l * D, 1.f, scr, kb * 64, nb * 32, lane); return; } r -= CV_MKV;
    if (r < CV_B) { const int kb = r / 81, nb = r % 81, n0 = nb * 32, k0 = kb * 64; unsigned char* WB = ws + WS_WB;
        if (n0 < 1536) cvt_item8(A.in[12], 1548, WB, D, n0, nkv, F8_SW, scr, k0, n0, lane);
        else if (n0 < 2560) cvt_item8(A.in[11], 1024, WB, D, n0, nmix + D, C2 * F8_SW, scr, k0, n0 - 1536, lane);
        else cvt_item8(A.in[12], 1548, WB, D, 2560, nkv, F8_SW, scr, k0, 0, lane, 1536, 12);
        return; } r -= CV_B;
    if (r < CV_O) { const int l = r / (KB * 32), rr = r % (KB * 32), kb = rr / 32, nb = rr % 32;
        cvt_item(A.in[15] + (size_t)l * D * D, D, 0, 1 << 30, (bf16*)(ws + (l ? WS_WO1 : WS_WO0)), D, nb * 32, nullptr, 1.f, scr, kb * 64, nb * 32, lane); return; } r -= CV_O;
    if (r < CV_GU) { const int up = r / (KB * 88), rr = r % (KB * 88), kb = rr / 88, nb = rr % 88, n0 = nb * 32;
        cvt_item(up ? A.in[17] : A.in[16], FF, 0, 1 << 30, (bf16*)(ws + WS_WGU0), D, 256 * (n0 >> 7) + 128 * up + (n0 & 127), nffn, 1.f, scr, kb * 64, n0, lane);
        return; } r -= CV_GU;
    if (r < CV_D) { const int kb = r / 32, nb = r % 32; cvt_item(A.in[18], D, 0, 1 << 30, (bf16*)(ws + WS_WD0), FF, nb * 32, nullptr, 1.f, scr, kb * 64, nb * 32, lane); return; } r -= CV_D;
    if (r < 2 * CV_MG) { const int up = r / CV_MG, r2 = r % CV_MG, e = r2 / (KB * 88), rr = r2 % (KB * 88), kb = rr / 88, nb = rr % 88, n0 = nb * 32;
        cvt_item8((up ? A.in[21] : A.in[20]) + (size_t)e * D * FF, FF, ws + WS_WGUM + (size_t)e * 5632 * D, D, 256 * (n0 >> 7) + 128 * up + (n0 & 127), nffn + D, F8_SW, scr, kb * 64, n0, lane); return; } r -= 2 * CV_MG;
    { const int e = r / (44 * 32), rr = r % (44 * 32), kb = rr / 32, nb = rr % 32;
        cvt_item8(A.in[22] + (size_t)e * FF * D, D, ws + WS_WDM + (size_t)e * D * WDP, WDP, nb * 32, nullptr, F8_SW, scr, kb * 64, nb * 32, lane); }
}
struct MoeItem { const float* W; unsigned char* WT; const float* gain; int ldw, ldt, drow, k0, n0; };
__device__ __forceinline__ MoeItem moe_item(const Args& A, int r) {
    MoeItem m; constexpr int KB = CV_KB;
    if (r < 2 * CV_MG) { const int up = r / CV_MG, r2 = r % CV_MG, e = r2 / (KB * 88), rr = r2 % (KB * 88), kb = rr / 88, nb = rr % 88, n0 = nb * 32;
        m.W = (up ? A.in[21] : A.in[20]) + (size_t)e * D * FF; m.ldw = FF; m.WT = A.ws + WS_WGUM + (size_t)e * 5632 * D; m.ldt = D; m.drow = 256 * (n0 >> 7) + 128 * up + (n0 & 127); m.gain = A.in[4] + D; m.k0 = kb * 64; m.n0 = n0; }
    else { r -= 2 * CV_MG; const int e = r / (44 * 32), rr = r % (44 * 32), kb = rr / 32, nb = rr % 32;
        m.W = A.in[22] + (size_t)e * FF * D; m.ldw = D; m.WT = A.ws + WS_WDM + (size_t)e * D * WDP; m.ldt = WDP; m.drow = nb * 32; m.gain = nullptr; m.k0 = kb * 64; m.n0 = nb * 32; }
    return m;
}
__device__ __forceinline__ void p_moe_weights(const Args& A, LAS unsigned char* lds, int gw, int NGW, int wave, int lane, int lo, int NI) {
    LAS float* scr = (LAS float*)(lds + RING_OFF + wave * 16384);
    const LAS float* gl = scr + 2176;
    for (int j = 0; j < 4; ++j) ((LAS f32x4*)(scr + 2176))[lane + 64 * j] = ((const GAS f32x4*)(A.in[4] + D))[lane + 64 * j];
    LDS_WAIT(); asm volatile("" ::: "memory");
    f32x4 va[8], vb[8], vc[8], vd[8]; int it = lo + gw;
#define MW_LOAD(buf, idx) { const MoeItem m = moe_item(A, (idx) < NI ? (idx) : NI - 1); cvt8_load4(buf, m.W, m.ldw, m.k0, m.n0, lane); }
#define MW_FIN(buf, idx) if ((idx) < NI) { const MoeItem m = moe_item(A, (idx)); cvt8_finish4(buf, m.WT, m.ldt, m.drow, m.gain ? gl : (const LAS float*)nullptr, F8_SW, m.k0, lane); }
    MW_LOAD(va, it) MW_LOAD(vb, it + NGW) MW_LOAD(vc, it + 2 * NGW)
#pragma unroll 1
    for (; it < NI; it += 4 * NGW) {
        MW_LOAD(vd, it + 3 * NGW) MW_FIN(va, it)
        MW_LOAD(va, it + 4 * NGW) MW_FIN(vb, it + NGW)
        MW_LOAD(vb, it + 5 * NGW) MW_FIN(vc, it + 2 * NGW)
        MW_LOAD(vc, it + 6 * NGW) MW_FIN(vd, it + 3 * NGW)
    }
#undef MW_LOAD
#undef MW_FIN
}
struct DItem { const float* W; unsigned char* WT; const float* gain; float scale; int ldw, ldtb, drow, k0, srcc, nvalid; bool f8; };
__device__ __forceinline__ DItem dense_item(const Args& A, int it) {
    DItem m; unsigned char* ws = A.ws; constexpr int KB = CV_KB; int r = it; m.nvalid = 32; m.gain = nullptr; m.scale = 1.f; m.f8 = false;
    if (r < CV_A) { const int kb = r / 81, nb = r % 81, n0 = nb * 32; m.k0 = kb * 64; m.W = A.in[7]; m.ldw = 2576; m.WT = ws + WS_WA; m.ldtb = D * 2; m.drow = n0; m.gain = A.in[2];
        if (n0 < 384) { m.srcc = n0; m.scale = 0.10206207261596575f  ; } else if (n0 < 2304) { m.srcc = n0; } else if (n0 < 2560) { m.srcc = 2320 + (n0 - 2304); m.scale = C2; } else { m.srcc = 2304; m.nvalid = 16; }
        return m; } r -= CV_A;
    if (r < CV_MKV) { const int l = r / (KB * 16), rr = r % (KB * 16), kb = rr / 16, nb = rr % 16;
        m.W = A.in[14] + (size_t)l * D * 512; m.ldw = 512; m.srcc = nb * 32; m.WT = ws + WS_WMKV; m.ldtb = D * 2; m.drow = 512 * l + nb * 32; m.gain = A.in[3] + l * D; m.k0 = kb * 64; return m; } r -= CV_MKV;
    if (r < CV_B) { const int kb = r / 81, nb = r % 81, n0 = nb * 32; m.k0 = kb * 64; m.WT = ws + WS_WB; m.ldtb = D; m.f8 = true; m.drow = n0;
        if (n0 < 1536) { m.W = A.in[12]; m.ldw = 1548; m.srcc = n0; m.gain = A.in[5]; m.scale = F8_SW; }
        else if (n0 < 2560) { m.W = A.in[11]; m.ldw = 1024; m.srcc = n0 - 1536; m.gain = A.in[2] + D; m.scale = C2 * F8_SW; }
        else { m.W = A.in[12]; m.ldw = 1548; m.srcc = 1536; m.gain = A.in[5]; m.scale = F8_SW; m.nvalid = 12; }
        return m; } r -= CV_B;
    if (r < CV_O) { const int l = r / (KB * 32), rr = r % (KB * 32), kb = rr / 32, nb = rr % 32;
        m.W = A.in[15] + (size_t)l * D * D; m.ldw = D; m.srcc = nb * 32; m.WT = ws + (l ? WS_WO1 : WS_WO0); m.ldtb = D * 2; m.drow = nb * 32; m.k0 = kb * 64; return m; } r -= CV_O;
    if (r < CV_GU) { const int up = r / (KB * 88), rr = r % (KB * 88), kb = rr / 88, nb = rr % 88, n0 = nb * 32;
        m.W = up ? A.in[17] : A.in[16]; m.ldw = FF; m.srcc = n0; m.WT = ws + WS_WGU0; m.ldtb = D * 2; m.drow = 256 * (n0 >> 7) + 128 * up + (n0 & 127); m.gain = A.in[4]; m.k0 = kb * 64; return m; } r -= CV_GU;
    { const int kb = r / 32, nb = r % 32; m.W = A.in[18]; m.ldw = D; m.srcc = nb * 32; m.WT = ws + WS_WD0; m.ldtb = FF * 2; m.drow = nb * 32; m.k0 = kb * 64; }
    return m;
}
struct DBuf { f32x4 v[8]; f32x4 g0, g1; };
__device__ __forceinline__ void dense_load(DBuf& b, const DItem& m, int lane) {
    const int l3 = lane >> 3, l7 = lane & 7, l7e = (4 * l7 < m.nvalid) ? l7 : 0;
    const GAS float* p = (const GAS float*)(m.W + (size_t)(m.k0 + 8 * l3) * m.ldw + m.srcc + 4 * l7e);
#pragma unroll
    for (int i = 0; i < 8; ++i) b.v[i] = __builtin_nontemporal_load((const GAS f32x4*)(p + (size_t)i * m.ldw));
    const GAS f32x4* gp = (const GAS f32x4*)(m.gain ? (const float*)(m.gain + m.k0 + 8 * l3) : (const float*)m.W);
    b.g0 = gp[0]; b.g1 = gp[1];
}
__device__ __forceinline__ void dense_finish(const DBuf& b, const DItem& m, int lane) {
    const int l3 = lane >> 3, l7 = lane & 7; const bool ok = 4 * l7 < m.nvalid;
    f32x4 g0 = {m.scale, m.scale, m.scale, m.scale}, g1 = g0;
    if (m.gain) { g0 = b.g0 * m.scale; g1 = b.g1 * m.scale; }
    if (!ok) { g0 = (f32x4){0.f, 0.f, 0.f, 0.f}; g1 = g0; }
    unsigned char* o8 = m.WT + (size_t)(m.drow + 4 * l7) * m.ldtb + (size_t)(m.k0 + 8 * l3) * (m.f8 ? 1 : 2);
    if (m.f8) { typedef unsigned u32x2 __attribute__((ext_vector_type(2)));
#pragma unroll
        for (int j = 0; j < 4; ++j) { u32x2 o;
            o.x = pg8::pack_fp8x4(b.v[0][j] * g0.x, b.v[1][j] * g0.y, b.v[2][j] * g0.z, b.v[3][j] * g0.w); o.y = pg8::pack_fp8x4(b.v[4][j] * g1.x, b.v[5][j] * g1.y, b.v[6][j] * g1.z, b.v[7][j] * g1.w);
            *(GAS u32x2*)(o8 + (size_t)j * m.ldtb) = o; } }
    else {
#pragma unroll
        for (int j = 0; j < 4; ++j) { v4u o;
            o.x = pk2(b.v[0][j] * g0.x, b.v[1][j] * g0.y); o.y = pk2(b.v[2][j] * g0.z, b.v[3][j] * g0.w); o.z = pk2(b.v[4][j] * g1.x, b.v[5][j] * g1.y); o.w = pk2(b.v[6][j] * g1.z, b.v[7][j] * g1.w);
            *(GAS v4u*)(o8 + (size_t)j * m.ldtb) = o; } }
}
__device__ __forceinline__ void p_dense_weights(const Args& A, LAS unsigned char* lds, int gw, int NGW, int wave, int lane) {
    DBuf a, b, c; int it = CV_P1 + gw;
#define DW_LOAD(buf, idx) { const DItem m = dense_item(A, (idx) < CV_DENSE ? (idx) : CV_DENSE - 1); dense_load(buf, m, lane); }
#define DW_FIN(buf, idx) if ((idx) < CV_DENSE) { const DItem m = dense_item(A, (idx)); dense_finish(buf, m, lane); }
    DW_LOAD(a, it) DW_LOAD(b, it + NGW) DW_LOAD(c, it + 2 * NGW)
#pragma unroll 1
    for (; it < CV_DENSE; it += 3 * NGW) {
        DW_FIN(a, it) DW_LOAD(a, it + 3 * NGW)
        DW_FIN(b, it + NGW) DW_LOAD(b, it + 4 * NGW)
        DW_FIN(c, it + 2 * NGW) DW_LOAD(c, it + 5 * NGW)
    }
#undef DW_LOAD
#undef DW_FIN
    { const v4u z = {0u, 0u, 0u, 0u}; unsigned char* WB = A.ws + WS_WB;
      for (int i = gw * 64 + lane; i < 224 * 64; i += NGW * 64) *((GAS v4u*)(WB + (size_t)2592 * D) + i) = z; }
}

__device__ __forceinline__ void p_prologue(const Args& A, LAS unsigned char* lds, int gw, int NGW, int wave, int lane) {
    unsigned char* ws = A.ws;
    DBuf cva; { const DItem m = dense_item(A, gw < CV_P1 ? gw : CV_P1 - 1); dense_load(cva, m, lane); }
    { const v4u z = {0u, 0u, 0u, 0u}; bf16* WA = (bf16*)(ws + WS_WA);
      for (int i = gw * 64 + lane; i < 224 * 128; i += NGW * 64) *((GAS v4u*)(WA + (size_t)2592 * D) + i) = z; }
    bf16* XB = (bf16*)(ws + WS_X); bf16* XM = (bf16*)(ws + WS_XM);
    for (int m = gw; m < T; m += NGW) (void)rms_row_to_bf16(A.in[0] + (size_t)m * D, XB + (size_t)m * D, lane);
    for (int m = gw; m < TM; m += NGW) (void)rms_row_to_bf16(A.in[1] + (size_t)m * D, XM + (size_t)m * D, lane);
    if (gw < CV_P1) { const DItem m = dense_item(A, gw); dense_finish(cva, m, lane); }
    for (int it = gw + NGW; it < CV_P1; it += NGW) { const DItem m = dense_item(A, it); dense_load(cva, m, lane); dense_finish(cva, m, lane); }
}

namespace gla {
typedef short bf16x8 __attribute__((ext_vector_type(8)));
constexpr int SQ = 104, S64 = 72, OSQ = 200;
constexpr int O_QD = 0, O_KD = O_QD + 64 * SQ * 2, O_KR = O_KD + 64 * SQ * 2, O_QR = O_KR + 64 * SQ * 2, O_KLT = O_QR + 64 * SQ * 2, O_VT = O_KLT + 96 * S64 * 2, O_P = O_VT + 192 * S64 * 2, O_ST = O_P + 64 * S64 * 2;
constexpr int O_GLR = O_ST + 192 * SQ * 2, O_W2 = O_GLR + 4096, O_B2 = O_W2 + 6144, O_SEG = O_B2 + 384, O_EBL = O_SEG + 1536, O_BTOT = O_EBL + 384, O_BBASE = O_BTOT + 384, O_END = O_BBASE + 384;
constexpr int O_OS = O_KD;
constexpr int O_OL = 0, O_RL = 64 * OSQ * 2;
static_assert(O_END <= RING_BYTES && 64 * OSQ * 2 <= 2 * 64 * SQ * 2 && 2 * 64 * OSQ * 2 <= O_ST, "gla LDS");
#define MFMA16(a, b, c) __builtin_amdgcn_mfma_f32_16x16x32_bf16((a), (b), (c), 0, 0, 0)
#define FRAG(off) (*(const LAS bf16x8*)(lds + (off)))
typedef short s16x4 __attribute__((ext_vector_type(4)));
__device__ __forceinline__ int vfrag_lane(int base, int lane) { const int g = lane >> 4, q = (lane >> 2) & 3, p = lane & 3; return base + ((8 * g + q) * OSQ + 4 * p) * 2; }
__device__ __forceinline__ bf16x8 vfrag(LAS unsigned char* lds, int lanebase, int ks, int c) {
    const int a0 = lanebase + (32 * ks * OSQ + 16 * c) * 2;
    const s16x4 lo = __builtin_bit_cast(s16x4, __builtin_amdgcn_ds_read_tr16_b64_v4i16((LAS s16x4*)(lds + a0))), hi = __builtin_bit_cast(s16x4, __builtin_amdgcn_ds_read_tr16_b64_v4i16((LAS s16x4*)(lds + a0 + 4 * OSQ * 2)));
    return (bf16x8){lo[0], lo[1], lo[2], lo[3], hi[0], hi[1], hi[2], hi[3]};
}
__device__ __forceinline__ void pass1(LAS unsigned char* lds, bf16* Y, const float* glrf, const float* w2, const float* b2, float* DS, float* DD, int unit, const bool DRY, unsigned long long* mk = nullptr) {
#define GMARK(i) do { if (mk && tid == 0 && n == 3) mk[i] = __builtin_amdgcn_s_memrealtime(); } while (0)
    const int tid = threadIdx.x, lane = tid & 63, w = __builtin_amdgcn_readfirstlane(tid >> 6), l15 = lane & 15, quad = lane >> 4;
    const int bh = unit >> 4, g = unit & 15, b = bh >> 2, h = bh & 3;
    const size_t row0 = (size_t)b * SEQ + (size_t)g * 512;
    LAS bf16* QD = (LAS bf16*)(lds + O_QD); LAS bf16* KD = (LAS bf16*)(lds + O_KD); LAS bf16* KR = (LAS bf16*)(lds + O_KR); LAS bf16* QR = (LAS bf16*)(lds + O_QR);
    LAS bf16* KLT = (LAS bf16*)(lds + O_KLT); LAS bf16* VT = (LAS bf16*)(lds + O_VT); LAS bf16* P = (LAS bf16*)(lds + O_P); LAS bf16* ST = (LAS bf16*)(lds + O_ST); LAS bf16* OS = (LAS bf16*)(lds + O_OS);
    LAS float* GLR = (LAS float*)(lds + O_GLR); LAS float* W2 = (LAS float*)(lds + O_W2); LAS float* B2 = (LAS float*)(lds + O_B2); LAS float* SEG = (LAS float*)(lds + O_SEG);
    LAS float* EBL = (LAS float*)(lds + O_EBL); LAS float* BTOT = (LAS float*)(lds + O_BTOT); LAS float* BBASE = (LAS float*)(lds + O_BBASE);
    for (int i = tid; i < 16 * 96; i += NTHR) W2[i] = w2[(i / 96) * 384 + h * 96 + (i % 96)];
    if (tid < 96) { B2[tid] = b2[h * 96 + tid]; BBASE[tid] = 0.f; }
    for (int i = tid; i < 192 * SQ * 2 / 16; i += NTHR) ((LAS v4u*)ST)[i] = (v4u){0u, 0u, 0u, 0u};
    f32x4 sacc[9];
#pragma unroll
    for (int i = 0; i < 9; ++i) sacc[i] = (f32x4){0.f, 0.f, 0.f, 0.f};
    v4u qk[3], vv[3]; f32x4 gl = (f32x4){0.f, 0.f, 0.f, 0.f};
#define GLA_LOADS(r0_, tq_) do { _Pragma("unroll") for (int it = 0; it < 3; ++it) { const int i = (tq_) + NTHR * it; const int row = i / 24, c = i % 24; \
        qk[it] = *(const v4u*)(Y + ((r0_) + row) * LDY + (c < 12 ? Y_Q + h * 96 + c * 8 : Y_K + h * 96 + (c - 12) * 8)); \
        vv[it] = *(const v4u*)(Y + ((r0_) + row) * LDY + Y_V + h * 192 + c * 8); } \
        if ((tq_) < 256) gl = *(const f32x4*)(glrf + (r0_) * 16 + (tq_) * 4); } while (0)
    GLA_LOADS(row0, tid);
    __syncthreads();
    float w2r[16]; float b2r;
    { const int kc_ = tid % 96;
#pragma unroll
      for (int j = 0; j < 16; ++j) w2r[j] = W2[j * 96 + kc_];
      b2r = B2[kc_]; }
#pragma unroll 1
    for (int n = 0; n < 8; ++n) {
        GMARK(10);
        const size_t r0 = row0 + (size_t)n * 64;
        int tq = tid; asm volatile("" : "+v"(tq));
        int vlb = vfrag_lane(O_VT, tq & 63); asm volatile("" : "+v"(vlb));
#pragma unroll
        for (int it = 0; it < 3; ++it) { const int i = tq + NTHR * it; const int row = i / 24, c = i % 24;
            *(LAS v4u*)((c < 12 ? QR : KR) + row * SQ + (c % 12) * 8) = qk[it];
            *(LAS v4u*)(VT + row * OSQ + c * 8) = vv[it]; }
        if (tq < 256) *(LAS f32x4*)(GLR + tq * 4) = gl;
        if (n < 7) GLA_LOADS(r0 + 64, tq);
        __syncthreads();
        GMARK(11);
        float la[16]; const int seg = tid / 96, kc = tid % 96;
        if (tid < 384) { float run = 0.f;
#pragma unroll
            for (int i = 0; i < 16; ++i) { const int t = seg * 16 + i; float z = b2r; const LAS f32x4* gp = (const LAS f32x4*)(GLR + t * 16);
#pragma unroll
                for (int j4 = 0; j4 < 4; ++j4) { const f32x4 g4 = gp[j4]; z += g4.x * w2r[4 * j4] + g4.y * w2r[4 * j4 + 1] + g4.z * w2r[4 * j4 + 2] + g4.w * w2r[4 * j4 + 3]; }
                const float ls = fminf(z, 0.f) - 0.6931471805599453f * __builtin_amdgcn_logf(1.0f + __builtin_amdgcn_exp2f(-fabsf(z) * LOG2E));
                run += ls * 0.0625f; la[i] = run; }
            SEG[seg * 96 + kc] = run; }
        __syncthreads();
        GMARK(12);
        if (tid < 384) {
            const float s0 = SEG[kc], s1 = SEG[96 + kc], s2 = SEG[192 + kc], s3 = SEG[288 + kc];
            const float pre = (seg > 0 ? s0 : 0.f) + (seg > 1 ? s1 : 0.f) + (seg > 2 ? s2 : 0.f), tot = (s0 + s1) + (s2 + s3), base = BBASE[kc];
            const float etot = __expf(tot), ebase = __expf(base);
            unsigned klp[8];
#pragma unroll
            for (int i = 0; i < 16; ++i) { const int t = seg * 16 + i; const float bt = la[i] + pre;
                const float qv = bf2f(QR[t * SQ + kc]), kv = bf2f(KR[t * SQ + kc]);
                const float e1 = __expf(bt), r1 = __builtin_amdgcn_rcpf(e1), qe = qv * e1, kr = kv * r1;
                const unsigned pq = pg8::cvt_pk_bf16(qe, kr), pb = pg8::cvt_pk_bf16(qe * ebase, kr * etot);
                QD[t * SQ + kc] = (bf16)(pq & 0xffffu); KD[t * SQ + kc] = (bf16)(pq >> 16);
                QR[t * SQ + kc] = (bf16)(pb & 0xffffu);
                const unsigned kl = pb >> 16;
                if (i & 1) klp[i >> 1] |= kl << 16; else klp[i >> 1] = kl; }
            LAS v4u* kd = (LAS v4u*)(KLT + kc * S64 + seg * 16);
            kd[0] = (v4u){klp[0], klp[1], klp[2], klp[3]}; kd[1] = (v4u){klp[4], klp[5], klp[6], klp[7]};
            if (seg == 0) { EBL[kc] = etot; BTOT[kc] = tot; } }
        __syncthreads();
        GMARK(13);
        { const int ti = w >> 1;
#pragma unroll
          for (int jj = 0; jj < 2; ++jj) { const int tj = 2 * (w & 1) + jj; f32x4 acc = (f32x4){0.f, 0.f, 0.f, 0.f};
            if (tj <= ti) {
#pragma unroll
                for (int ks = 0; ks < 3; ++ks) acc = MFMA16(FRAG(O_QD + ((ti * 16 + l15) * SQ + ks * 32 + quad * 8) * 2), FRAG(O_KD + ((tj * 16 + l15) * SQ + ks * 32 + quad * 8) * 2), acc); }
#pragma unroll
            for (int j = 0; j < 4; ++j) { const int t = ti * 16 + 4 * quad + j, s = tj * 16 + l15; P[t * S64 + s] = (bf16)f2bf(s <= t ? acc[j] : 0.f); } } }
        __syncthreads();
        GMARK(14);
        { const int tr = w & 3, vb0 = (w >> 2) * 6;
          bf16x8 pa[2], qa[3];
#pragma unroll
          for (int ks = 0; ks < 2; ++ks) pa[ks] = FRAG(O_P + ((tr * 16 + l15) * S64 + ks * 32 + quad * 8) * 2);
#pragma unroll
          for (int ks = 0; ks < 3; ++ks) qa[ks] = FRAG(O_QD + ((tr * 16 + l15) * SQ + ks * 32 + quad * 8) * 2);
#pragma unroll
          for (int i = 0; i < 6; ++i) { const int vb = vb0 + i; f32x4 acc = (f32x4){0.f, 0.f, 0.f, 0.f}; asm volatile("" : "+v"(acc));
#pragma unroll
            for (int ks = 0; ks < 2; ++ks) acc = MFMA16(vfrag(lds, vlb, ks, vb), pa[ks], acc);
#pragma unroll
            for (int ks = 0; ks < 3; ++ks) acc = MFMA16(FRAG(O_ST + ((vb * 16 + l15) * SQ + ks * 32 + quad * 8) * 2), qa[ks], acc);
            { typedef unsigned u32x2w __attribute__((ext_vector_type(2))); u32x2w o; o.x = attn_body::cvtpk_s(acc[0], acc[1]); o.y = attn_body::cvtpk_s(acc[2], acc[3]);
              *(LAS u32x2w*)(OS + (tr * 16 + l15) * OSQ + vb * 16 + 4 * quad) = o; } } }
        __syncthreads();
        GMARK(15);
#pragma unroll
        for (int i = 0; i < 9; ++i) { const int idx = w * 9 + i, kb = idx / 12, vb = idx % 12;
            const f32x4 dec = *(const LAS f32x4*)(EBL + kb * 16 + 4 * quad);
            f32x4 acc = sacc[i] * dec;
#pragma unroll
            for (int ks = 0; ks < 2; ++ks) acc = MFMA16(FRAG(O_KLT + ((kb * 16 + l15) * S64 + ks * 32 + quad * 8) * 2), vfrag(lds, vlb, ks, vb), acc);
            sacc[i] = acc;
            *(LAS unsigned long long*)(ST + (vb * 16 + l15) * SQ + kb * 16 + 4 * quad) = (unsigned long long)pk2(acc[0], acc[1]) | ((unsigned long long)pk2(acc[2], acc[3]) << 32); }
        int td = tid; asm volatile("" : "+v"(td));
#pragma unroll
        for (int it = 0; it < 3; ++it) { const int i = td + NTHR * it; const int row = i / 24, c = i % 24;
            *(v4u*)(Y + (r0 + row) * LDY + (DRY ? 2592 : Y_V + h * 192) + c * 8) = *(const LAS v4u*)(OS + row * OSQ + c * 8); }
#pragma unroll
        for (int it = 0; it < 2; ++it) { const int i = td + NTHR * it; if (i < 768) { const int row = i / 12, c = i % 12;
            *(v4u*)(Y + (r0 + row) * LDY + (DRY ? 2592 : Y_Q + h * 96) + c * 8) = *(const LAS v4u*)(QR + row * SQ + c * 8); } }
        if (tid < 96) BBASE[tid] += BTOT[tid];
        __syncthreads();
        GMARK(16);
    }
#undef GLA_LOADS
#undef GMARK
#pragma unroll
    for (int i = 0; i < 9; ++i) { const int idx = w * 9 + i, kb = idx / 12, vb = idx % 12; float* d = DS + ((size_t)(unit + (DRY ? 256 : 0)) * 96 + kb * 16 + 4 * quad) * 192 + vb * 16 + l15;
#pragma unroll
        for (int j = 0; j < 4; ++j) d[j * 192] = sacc[i][j]; }
    if (tid < 96) DD[(unit + (DRY ? 256 : 0)) * 96 + tid] = __expf(BBASE[tid]);
    __syncthreads();
}
__device__ __forceinline__ void prefix(float* DS, const float* DD, int unit) {
    const int tid = threadIdx.x, bh = unit >> 4, part = unit & 15;
#pragma unroll 1
    for (int i = 0; i < 3; ++i) { const int e = tid + NTHR * i; if (e < 1152) { const int idx = part * 1152 + e, k = idx / 192;
        float v[16], d[16];
#pragma unroll
        for (int g = 0; g < 16; ++g) { v[g] = DS[(size_t)(bh * 16 + g) * 96 * 192 + idx]; d[g] = DD[(bh * 16 + g) * 96 + k]; }
        float S = 0.f;
#pragma unroll
        for (int g = 0; g < 16; ++g) { DS[(size_t)(bh * 16 + g) * 96 * 192 + idx] = S; S = d[g] * S + v[g]; } } }
}
__device__ __forceinline__ void pass3(LAS unsigned char* lds, bf16* Y, const float* onorm, const float* DS, const float* DD, int unit, const bool DRY) {
    const int tid = threadIdx.x, lane = tid & 63, w = __builtin_amdgcn_readfirstlane(tid >> 6), l15 = lane & 15, quad = lane >> 4;
    const int bh = unit >> 4, g = unit & 15, b = bh >> 2, h = bh & 3;
    const size_t row0 = (size_t)b * SEQ + (size_t)g * 512;
    LAS bf16* ST = (LAS bf16*)(lds + O_ST); LAS float* ON = (LAS float*)(lds + O_GLR); LAS float* SS = (LAS float*)(lds + O_W2);
    LAS bf16* OL = (LAS bf16*)(lds + O_OL); LAS bf16* RL = (LAS bf16*)(lds + O_RL);
    { const float* ds = DS + (size_t)unit * 96 * 192;
#pragma unroll
      for (int i = 0; i < 36; ++i) { const int idx = tid + NTHR * i; ST[(idx % 192) * SQ + idx / 192] = (bf16)f2bf(ds[idx]); } }
    if (tid < 192) ON[tid] = onorm[tid];
    const int tr = w & 3, vb0 = (w >> 2) * 6;
    v4u ol[3], rl[3]; bf16x8 qn[3];
#define GLA_LOADS3(r0_, tq_) do { _Pragma("unroll") for (int it = 0; it < 3; ++it) { const int i = (tq_) + NTHR * it; const int row = i / 24, c = i % 24; \
        ol[it] = *(const v4u*)(Y + ((r0_) + row) * LDY + Y_V + h * 192 + c * 8); rl[it] = *(const v4u*)(Y + ((r0_) + row) * LDY + Y_R + h * 192 + c * 8); } \
        _Pragma("unroll") for (int ks = 0; ks < 3; ++ks) qn[ks] = *(const bf16x8*)(Y + ((r0_) + tr * 16 + l15) * LDY + Y_Q + h * 96 + ks * 32 + quad * 8); } while (0)
    GLA_LOADS3(row0, tid);
    __syncthreads();
#pragma unroll 1
    for (int n = 0; n < 8; ++n) {
        const size_t r0 = row0 + (size_t)n * 64;
        int tq = tid; asm volatile("" : "+v"(tq));
#pragma unroll
        for (int it = 0; it < 3; ++it) { const int i = tq + NTHR * it; const int row = i / 24, c = i % 24;
            *(LAS v4u*)(OL + row * OSQ + c * 8) = ol[it]; *(LAS v4u*)(RL + row * OSQ + c * 8) = rl[it]; }
        bf16x8 qa[3];
#pragma unroll
        for (int ks = 0; ks < 3; ++ks) qa[ks] = qn[ks];
        if (n < 7) GLA_LOADS3(r0 + 64, tq);
        __syncthreads();
        f32x4 acc[6]; float ssq = 0.f; const int trow = tr * 16 + l15;
        typedef unsigned u32x2v __attribute__((ext_vector_type(2)));
#pragma unroll
        for (int i = 0; i < 6; ++i) { const int vb = vb0 + i; f32x4 a = (f32x4){0.f, 0.f, 0.f, 0.f};
#pragma unroll
            for (int ks = 0; ks < 3; ++ks) a = MFMA16(FRAG(O_ST + ((vb * 16 + l15) * SQ + ks * 32 + quad * 8) * 2), qa[ks], a);
            const u32x2v o2 = *(const LAS u32x2v*)(OL + trow * OSQ + vb * 16 + 4 * quad);
            a[0] += __uint_as_float(o2.x << 16); a[1] += __uint_as_float(o2.x & 0xffff0000u); a[2] += __uint_as_float(o2.y << 16); a[3] += __uint_as_float(o2.y & 0xffff0000u);
            ssq += (a[0] * a[0] + a[1] * a[1]) + (a[2] * a[2] + a[3] * a[3]);
            acc[i] = a; }
        ssq += __shfl_xor(ssq, 16); ssq += __shfl_xor(ssq, 32);
        if (quad == 0) SS[trow * 2 + (w >> 2)] = ssq;
        __syncthreads();
        const float rs = 1.0f / sqrtf((SS[trow * 2] + SS[trow * 2 + 1]) * (1.f / 192.f) + EPS);
#pragma unroll
        for (int i = 0; i < 6; ++i) { const int dv0 = (vb0 + i) * 16 + 4 * quad; const f32x4 gn = *(const LAS f32x4*)(ON + dv0);
            const u32x2v r2 = *(const LAS u32x2v*)(RL + trow * OSQ + dv0);
            const float r0f = __uint_as_float(r2.x << 16), r1f = __uint_as_float(r2.x & 0xffff0000u), r2f = __uint_as_float(r2.y << 16), r3f = __uint_as_float(r2.y & 0xffff0000u);
            u32x2v o; o.x = pg8::cvt_pk_bf16(acc[i][0] * rs * gn[0] * pg8::silu_f(r0f), acc[i][1] * rs * gn[1] * pg8::silu_f(r1f)); o.y = pg8::cvt_pk_bf16(acc[i][2] * rs * gn[2] * pg8::silu_f(r2f), acc[i][3] * rs * gn[3] * pg8::silu_f(r3f));
            *(LAS u32x2v*)(OL + trow * OSQ + dv0) = o; }
        __syncthreads();
        int td = tid; asm volatile("" : "+v"(td));
#pragma unroll
        for (int it = 0; it < 3; ++it) { const int i = td + NTHR * it; const int row = i / 24, c = i % 24;
            *(v4u*)(Y + (r0 + row) * LDY + (DRY ? 2592 : Y_R + h * 192) + c * 8) = *(const LAS v4u*)(OL + row * OSQ + c * 8); }
    }
#undef GLA_LOADS3
}
#undef MFMA16
#undef FRAG
}

constexpr int N_PHASES = 19;
__global__ void __launch_bounds__(NTHR, 2) fwd_kernel(Args args) {
    extern __shared__ __attribute__((aligned(16))) unsigned char lds_raw[];
    LAS unsigned char* lds = (LAS unsigned char*)lds_raw;
    volatile LAS unsigned* MISC = (volatile LAS unsigned*)(lds + MISC_OFF);
    const int wave = __builtin_amdgcn_readfirstlane((int)threadIdx.x >> 6);
#define PH_TID() int tid = threadIdx.x; asm volatile("" : "+v"(tid)); const int lane = tid & 63; (void)lane
    const int G = gridDim.x; const int bx = blockIdx.x; const int vcu = (G % 8 == 0) ? (bx % 8) * (G / 8) + bx / 8 : bx;
    const int gw = vcu * NWAVES + wave, NGW = G * NWAVES;
    unsigned char* ws = args.ws;
    gu32* ctl = (gu32*)(ws + WS_CTL);
    { PH_TID(); for (int u = tid; u < (LDS_BYTES - LDSCTL_OFF) / 4; u += NTHR) ((LAS unsigned*)(lds + LDSCTL_OFF))[u] = 0u; }
    __syncthreads();
    const bool multi = (args.ph_hi - args.ph_lo) > 1;
    XcdBarrier bar; bar.bar = (unsigned*)(ctl + CW_BAR); bar.x = 0; bar.st = nullptr;
    if (multi) bar = xcd_barrier_post((unsigned*)(ctl + CW_BAR), MISC + 8);
    const int lo = args.ph_lo, hi = args.ph_hi;
#ifdef PROBE_Q
#ifndef PROBE_P2
#define PROBE_P2 0
#endif
    unsigned long long* stamps = (unsigned long long*)(ws + 768 * 1024);
    if (threadIdx.x == 0 && blockIdx.x == 0) stamps[96] = __builtin_amdgcn_s_memrealtime();
#endif
#define IN(k) (lo <= (k) && (k) < hi)
#ifdef PROBE_Q
#ifndef PROBE_BLK
#define PROBE_BLK 0
#endif
#define MARK(i) do { if (threadIdx.x == 0 && blockIdx.x == PROBE_BLK) stamps[160 + (i)] = __builtin_amdgcn_s_memrealtime(); } while (0)
#define STAMP_BAR(pos) do { if (threadIdx.x == 0) { const unsigned long long t_ = __builtin_amdgcn_s_memrealtime(); atomicMax(stamps + 32 + (pos), t_); atomicMax(stamps + (pos), ~t_); if (blockIdx.x == PROBE_BLK) stamps[128 + (pos)] = t_; } \
        xcd_barrier(bar); if (threadIdx.x == 0 && blockIdx.x == 0) stamps[64 + (pos)] = __builtin_amdgcn_s_memrealtime(); } while (0)
#else
#define STAMP_BAR(pos) xcd_barrier(bar)
#define MARK(i) do { } while (0)
#endif
#define SEAM(k) do { if (IN(k) && IN((k) + 1)) STAMP_BAR((k) <= 2 ? (k) : (k) + 1); } while (0)
#ifndef DUPMASK
#define DUPMASK 0
#endif
#define DUP(k) (((DUPMASK) >> (k)) & 1)
#ifndef G2SP2
#define G2SP2 true
#endif
#ifndef G2WGM
#define G2WGM 4
#endif
#define DRYBAR() xcd_barrier(bar)
#define REPS(k) _Pragma("unroll 1") for (int rep_ = DUP(k) ? 0 : 1; rep_ < 2; ++rep_)
#define REP_END() do { if (rep_ == 0) DRYBAR(); } while (0)
#define DRYSC(k) (DUP(k) ? (rep_ == 0 ? 0.0f : 1.0f) : 1.0f)

    bf16* Y = (bf16*)(ws + WS_Y); bf16* XB = (bf16*)(ws + WS_X); bf16* HB = (bf16*)(ws + WS_Y);
    float* SIDE = (float*)(ws + WS_SIDE); float* CS = (float*)(ws + WS_CS);
    bf16* MKV = (bf16*)(ws + WS_MKV);
    float* DSb = (float*)(ws + WS_DS); float* DDb = (float*)(ws + WS_DD);
    int* EID = (int*)(ws + WS_EID); float* GWT = (float*)(ws + WS_GW); float* RSTD = (float*)(ws + WS_RSTD);
    int* TOK = (int*)(ws + WS_TOK); float* GATE = (float*)(ws + WS_GATE); int* TILEE = (int*)(ws + WS_TILEE); int* CNTW = (int*)(ws + WS_TILEE + 8192); int* POS = (int*)(ws + WS_POS); float* KTN = (float*)(ws + WS_KT);
    float* OUT = args.out;

    if (IN(0)) { PH_TID(); if (DUP(0)) { p_prologue(args, lds, gw, NGW, wave, lane); DRYBAR(); } p_prologue(args, lds, gw, NGW, wave, lane); }
    SEAM(0);
    if (IN(1)) { REPS(1) {
        { pg8::Gemm g{XB, (const bf16*)(ws + WS_WA), T, LDY, D, D, D, 0}; pg8::StaticOrder S; S.init(T, LDY, G, bx);
          pg8::EpiBf16 E{Y, LDY, SIDE, 10, nullptr, 1.0f};
          pg8::gemm_phase<pg8::EpiBf16, pg8::StaticOrder, true, true>(lds + RING_OFF, g, S, E); }
        { pg8::Gemm g{(const bf16*)(ws + WS_XM), (const bf16*)(ws + WS_WMKV), TM, 1024, D, D, D, 0}; pg8::StaticOrder S; S.init(TM, 1024, G, (bx + G - (G / 2)) % G);
          pg8::EpiBf16 E{MKV, 1024, nullptr, -1, nullptr, 1.0f};
          pg8::gemm_phase<pg8::EpiBf16, pg8::StaticOrder, true, true>(lds + RING_OFF, g, S, E); }
        REP_END(); }
    }
    SEAM(1);
    if (IN(2)) { MARK(0); REPS(2) {
        for (int u = vcu; u < 256; u += G) gla::pass1(lds + RING_OFF, Y, SIDE, args.in[8], args.in[9], DSb, DDb, u, rep_ == 0,
#ifdef PROBE_Q
            blockIdx.x == PROBE_BLK ? stamps + 160 : nullptr
#else
            nullptr
#endif
            );
        REP_END(); }
      MARK(1);
      REPS(20) {
        for (int u = vcu; u < 512; u += G) { const int qblk = u >> 2, h = u & 3, b = qblk >> 5;
            attn_body::attn_unit<8, false, false, LDY, 1024>((long)qblk * 256, (long)b * NMEM, 4, (const attn_body::bf16*)(Y + Y_MQ + h * 64), (const attn_body::bf16*)(MKV + h * 64), (const attn_body::bf16*)(MKV + 256 + h * 64),
                (attn_body::bf16*)(Y + (rep_ == 0 ? 2592 : Y_MQ + h * 64)), nullptr, (char*)lds_raw + RING_OFF); }
        REP_END(); }
      MARK(2);
      { PH_TID(); __syncthreads(); p_dense_weights(args, lds, gw, NGW, wave, lane); __syncthreads(); }
      MARK(3);
    }
    SEAM(2);
    if (IN(3)) { for (int u = vcu; u < 256; u += G) gla::prefix(DSb, DDb, u);
        STAMP_BAR(3);
        REPS(3) { for (int u = vcu; u < 256; u += G) gla::pass3(lds + RING_OFF, Y, args.in[10], DSb, DDb, u, rep_ == 0); REP_END(); } }
    SEAM(3);
    if (IN(4)) { REPS(4) { pg8::Gemm g{Y + MIX_OFF, (const bf16*)(ws + WS_WO0), T, D, D, LDY, D, 0}; pg8::StaticOrder S; S.init(T, D, G, bx);
        typedef pg8::EpiResF32<D, false, 0, 0, true> Epi4; Epi4 E{args.in[0], rep_ == 0 ? (float*)(ws + WS_X) : OUT, ws};
        pg8::gemm_phase<Epi4, pg8::StaticOrder, true, true>(lds + RING_OFF, g, S, E); REP_END(); } }
    SEAM(4);
    if (IN(5)) { PH_TID(); REPS(5) { for (int m = gw; m < T; m += NGW) (void)rms_row_to_bf16(OUT + (size_t)m * D, XB + (size_t)m * D, lane); REP_END(); } }
    SEAM(5);
    if (IN(6)) { REPS(6) { pg8::Gemm g{XB, (const bf16*)(ws + WS_WGU0), T, 2 * FF, D, D, D, 0}; pg8::StaticOrder S; S.init(T, 2 * FF, G, bx);
        pg8::EpiSwiGLU E{HB, FF, nullptr};
        pg8::gemm_phase<pg8::EpiSwiGLU, pg8::StaticOrder, true, true>(lds + RING_OFF, g, S, E); REP_END(); } }
    SEAM(6);
    if (IN(7)) { REPS(7) { pg8::Gemm g{HB, (const bf16*)(ws + WS_WD0), T, D, FF, FF, FF, 0}; pg8::StaticOrder S; S.init(T, D, G, bx);
        typedef pg8::EpiResF32<D, false, 0, 0> Epi7; Epi7 E{OUT, rep_ == 0 ? (float*)(ws + WS_X) : OUT, ws};
        pg8::gemm_phase<Epi7, pg8::StaticOrder, true, true>(lds + RING_OFF, g, S, E); REP_END(); } }
    SEAM(7);
    if (IN(8)) { PH_TID(); REPS(8) { unsigned char* XB8 = ws + WS_X;
        for (int m = gw; m < T; m += NGW) { const GAS f32x4* xr = (const GAS f32x4*)(OUT + (size_t)m * D) + lane; f32x4 v[4]; float s = 0.f;
#pragma unroll
            for (int j = 0; j < 4; ++j) { v[j] = __builtin_nontemporal_load(xr + 64 * j); s += (v[j].x * v[j].x + v[j].y * v[j].y) + (v[j].z * v[j].z + v[j].w * v[j].w); }
            const float rs8 = F8_SA / sqrtf(wave_sum(s) * (1.f / D) + EPS); GAS unsigned* o = (GAS unsigned*)(XB8 + (size_t)m * D) + lane;
#pragma unroll
            for (int j = 0; j < 4; ++j) o[64 * j] = pg8::pack_fp8x4(v[j].x * rs8, v[j].y * rs8, v[j].z * rs8, v[j].w * rs8); }
        REP_END(); } }
    SEAM(8);
#ifndef P9_SKINNY
#define P9_SKINNY 1
#endif
#if !P9_SKINNY
#error "the forget-logit side output is stored transposed by the skinny path only"
    if (IN(9)) { REPS(9) { pg8::Gemm g{XB, (const bf16*)(ws + WS_WB), T, LDY, D / 2, D / 2, D / 2, 0}; pg8::StaticOrder S; S.init(T, LDY, G, bx);
        pg8::EpiBf16 E{Y, LDY, SIDE, 10, nullptr, 1.0f};
        pg8::gemm_phase<pg8::EpiBf16, pg8::StaticOrder, true, true, true, 11>(lds + RING_OFF, g, S, E); REP_END(); } }
#else
    if (IN(9)) { REPS(9) { pg8::Gemm g{XB, (const bf16*)(ws + WS_WB), T, 2560, D / 2, D / 2, D / 2, 0}; pg8::StaticOrder S; S.init(T, 2560, G, bx);
        pg8::EpiBf16 E{Y, LDY, nullptr, -1, nullptr, 1.0f};
        pg8::gemm_phase<pg8::EpiBf16, pg8::StaticOrder, true, true, true, 11>(lds + RING_OFF, g, S, E);
        { PH_TID(); const int l15 = lane & 15, quad = lane >> 4; const unsigned char* wrow = ws + WS_WB + (size_t)(2560 + l15) * D + quad * 16;
          typedef unsigned long long u64x2 __attribute__((ext_vector_type(2)));
          for (int blk = vcu; blk < T / 128; blk += G) { const int row = blk * 128 + wave * 16 + l15; const unsigned char* arow = (const unsigned char*)XB + (size_t)row * D + quad * 16;
              f32x4 acc = {0.f, 0.f, 0.f, 0.f};
#pragma unroll 1
              for (int s0 = 0; s0 < 16; s0 += 8) { u64x2 wa[8], xa[8];
#pragma unroll
                  for (int i = 0; i < 8; ++i) { wa[i] = *(const GAS u64x2*)(wrow + (s0 + i) * 64); xa[i] = *(const GAS u64x2*)(arow + (s0 + i) * 64); }
#pragma unroll
                  for (int i = 0; i < 8; ++i) { acc = __builtin_amdgcn_mfma_f32_16x16x32_fp8_fp8((long)wa[i].x, (long)xa[i].x, acc, 0, 0, 0); acc = __builtin_amdgcn_mfma_f32_16x16x32_fp8_fp8((long)wa[i].y, (long)xa[i].y, acc, 0, 0, 0); } }
#pragma unroll
              for (int r4 = 0; r4 < 4; ++r4) SIDE[(size_t)(4 * quad + r4) * T + row] = acc[r4] * (1.0f / 2048.0f); } }
        REP_END(); } }
#endif
    SEAM(9);
    if (IN(10)) { PH_TID(); REPS(10) {
        for (int u = vcu; u < 48; u += G) { const int b = u / 12, h = u % 12; LAS float* sc = (LAS float*)(lds + RING_OFF);
            const float bf = args.in[13][h]; float v[16]; float run = 0.f;
            f32x4 z4[4]; { const f32x4* sp = (const f32x4*)(SIDE + (size_t)h * T + (size_t)b * SEQ + tid * 16); z4[0] = sp[0]; z4[1] = sp[1]; z4[2] = sp[2]; z4[3] = sp[3]; }
#pragma unroll
            for (int i = 0; i < 16; ++i) { const float z = z4[i >> 2][i & 3] + bf;
                run += fminf(z, 0.f) - 0.6931471805599453f * __builtin_amdgcn_logf(1.0f + __builtin_amdgcn_exp2f(-fabsf(z) * LOG2E)); v[i] = run; }
            sc[tid] = run; __syncthreads();
            if (tid < 64) { float a[8]; float s = 0.f;
#pragma unroll
                for (int i = 0; i < 8; ++i) { s += sc[tid * 8 + i]; a[i] = s; }
                float incl = s;
#pragma unroll
                for (int o = 1; o < 64; o <<= 1) { const float t2 = __shfl_up(incl, o); if (lane >= o) incl += t2; }
                const float excl = incl - s;
#pragma unroll
                for (int i = 0; i < 8; ++i) sc[512 + tid * 8 + i] = excl + a[i]; }
            __syncthreads();
            const float pre = sc[512 + tid] - run;
#pragma unroll
            for (int i = 0; i < 16; ++i) CS[(size_t)u * SEQ + tid * 16 + i] = (v[i] + pre) * LOG2E;
            __syncthreads(); }
        for (int blk = vcu; blk < T / 128; blk += G) { LAS unsigned* LM = (LAS unsigned*)(lds + RING_OFF) + 2048;
            if (tid < 36) LM[tid] = 0u; else if (tid < 48) LM[tid] = 0xFFFFFFFFu;
            __syncthreads();
            const int r = tid >> 2, part = tid & 3; const bf16* yrow = Y + (size_t)(blk * 128 + r) * LDY;
#pragma unroll
            for (int hh = 0; hh < 3; ++hh) { const int h = part + 4 * hh; const v4u* pk = (const v4u*)(yrow + Z_K + h * 64); const v4u* pq = (const v4u*)(yrow + Z_Q + h * 64); float sk = 0.f, sq = 0.f, dt = 0.f;
#pragma unroll
                for (int c = 0; c < 8; ++c) { const v4u w = pk[c], z = pq[c];
#define BFLO(x) __uint_as_float((x) << 16)
#define BFHI(x) __uint_as_float((x) & 0xffff0000u)
                    const float a0 = BFLO(w.x), a1 = BFHI(w.x), a2 = BFLO(w.y), a3 = BFHI(w.y), a4 = BFLO(w.z), a5 = BFHI(w.z), a6 = BFLO(w.w), a7 = BFHI(w.w);
                    const float b0 = BFLO(z.x), b1 = BFHI(z.x), b2 = BFLO(z.y), b3 = BFHI(z.y), b4 = BFLO(z.z), b5 = BFHI(z.z), b6 = BFLO(z.w), b7 = BFHI(z.w);
#undef BFLO
#undef BFHI
                    sk += ((a0 * a0 + a1 * a1) + (a2 * a2 + a3 * a3)) + ((a4 * a4 + a5 * a5) + (a6 * a6 + a7 * a7));
                    sq += ((b0 * b0 + b1 * b1) + (b2 * b2 + b3 * b3)) + ((b4 * b4 + b5 * b5) + (b6 * b6 + b7 * b7));
                    dt += ((a0 * b0 + a1 * b1) + (a2 * b2 + a3 * b3)) + ((a4 * b4 + a5 * b5) + (a6 * b6 + a7 * b7)); }
                const unsigned db = __float_as_uint(dt), dkey = db ^ ((db >> 31) ? 0xFFFFFFFFu : 0x80000000u);
                __hip_atomic_fetch_max(LM + (r >> 6) * 12 + h, __float_as_uint(sk), __ATOMIC_RELAXED, __HIP_MEMORY_SCOPE_WORKGROUP);
                __hip_atomic_fetch_max(LM + 24 + h, __float_as_uint(sq), __ATOMIC_RELAXED, __HIP_MEMORY_SCOPE_WORKGROUP);
                __hip_atomic_fetch_min(LM + 36 + h, dkey, __ATOMIC_RELAXED, __HIP_MEMORY_SCOPE_WORKGROUP); }
            __syncthreads();
            { const int b = blk >> 6, bl = blk & 63;
              if (tid < 24) KTN[(size_t)(b * 12 + (tid % 12)) * 128 + 2 * bl + tid / 12] = __uint_as_float(LM[tid]);
              else if (tid < 36) KTN[48 * 128 + (size_t)(b * 12 + (tid - 24)) * 64 + bl] = __uint_as_float(LM[tid]);
              else if (tid < 48) { const unsigned k = LM[tid]; KTN[48 * 192 + (size_t)(b * 12 + (tid - 36)) * 64 + bl] = __uint_as_float((k & 0x80000000u) ? (k ^ 0x80000000u) : ~k); } }
            __syncthreads(); }
        for (int u = vcu; u < 512; u += G) { const int qblk = u >> 2, h = u & 3, b = qblk >> 5;
            attn_body::attn_unit<8, false, false, LDY, 1024>((long)qblk * 256, (long)b * NMEM, 4, (const attn_body::bf16*)(Y + Y_MQ + h * 64), (const attn_body::bf16*)(MKV + 512 + h * 64), (const attn_body::bf16*)(MKV + 768 + h * 64),
                (attn_body::bf16*)(Y + (rep_ == 0 ? 2592 : Y_MQ + h * 64)), nullptr, (char*)lds_raw + RING_OFF); }
        REP_END(); }
    }
    SEAM(10);
    if (IN(11)) { MARK(4);
      constexpr int NI_MOE = 2 * CV_MG + CV_MD, NI_EARLY = NI_MOE / 16 * CONV_F;
      const bool split = (G == 256);
      if (split && ((bx >> 3) % CONV_DIV) == 0) { PH_TID(); const int ci = (bx & 7) * (32 / CONV_DIV) + (bx >> 3) / CONV_DIV;
          p_moe_weights(args, lds, ci * NWAVES + wave, (256 / CONV_DIV) * NWAVES, wave, lane, 0, NI_EARLY); __syncthreads(); }
      MARK(8);
      REPS(11) {
        LAS int* qs = (LAS int*)(lds + LDSCTL_OFF + 64);
        for (;;) {
            if (threadIdx.x == 0) qs[0] = (int)__hip_atomic_fetch_add(ctl + CW_Q + 64 * rep_, 1u, RLX_AGENT);
            __syncthreads();
            const int slot = __builtin_amdgcn_readfirstlane(qs[0]);
            __syncthreads();
            if (slot >= 1536) break;
            const int ui = slot;
            const int qb = 31 - ui / 48, bh = ui % 48, b = bh / 12, h = bh % 12;
            int NT = 4 * qb + 4, t0 = 0;
            { const int ln = (int)(threadIdx.x & 63u); const float* KTb = KTN + (size_t)bh * 128; const float* csb = CS + (size_t)bh * SEQ;
              const float Qu = sqrtf(fmaxf(KTN[48 * 128 + bh * 64 + 2 * qb], KTN[48 * 128 + bh * 64 + 2 * qb + 1])) * 1.01f;
              const float Kb = sqrtf(fmaxf(fmaxf(KTb[4 * qb], KTb[4 * qb + 1]), fmaxf(KTb[4 * qb + 2], KTb[4 * qb + 3]))) * 1.01f;
              const float c0 = csb[qb * 256];
              const float dmin = fmaxf(fminf(KTN[48 * 192 + bh * 64 + 2 * qb], KTN[48 * 192 + bh * 64 + 2 * qb + 1]) - 0.01f, -Qu * Kb);
              bool ok0 = false, ok1 = false;
              if (ln < NT - 4) ok0 = Qu * (sqrtf(KTb[ln]) * 1.01f) - dmin + c0 - csb[64 * ln + 63] < -FOX_SKIP;
              if (ln + 64 < NT - 4) ok1 = Qu * (sqrtf(KTb[ln + 64]) * 1.01f) - dmin + c0 - csb[64 * (ln + 64) + 63] < -FOX_SKIP;
              const unsigned long long m0 = __ballot(ok0), m1 = __ballot(ok1);
              t0 = (~m0 != 0ull) ? __builtin_ctzll(~m0) : ((~m1 != 0ull) ? 64 + __builtin_ctzll(~m1) : 128);
              t0 = __builtin_amdgcn_readfirstlane(t0); if (t0 > NT - 4) t0 = NT - 4; t0 &= ~1; }
            NT -= t0;
#ifdef PROBE_Q
            if (threadIdx.x == 0 && blockIdx.x == PROBE_BLK) { stamps[160 + 21] += (unsigned long long)NT * 100ull; stamps[160 + 23] += 1000ull; }
#endif
            attn_body::attn_unit<60, true, true, LDY, LDY>((long)b * SEQ + qb * 256, (long)b * SEQ + 64 * t0, NT, (const attn_body::bf16*)(Y + Z_Q + h * 64), (const attn_body::bf16*)(Y + Z_K + h * 64), (const attn_body::bf16*)(Y + Z_V + h * 64),
                (attn_body::bf16*)(Y + (rep_ == 0 ? 2592 : Z_Q + h * 64)), CS + (size_t)bh * SEQ + 64 * t0, (char*)lds_raw + RING_OFF); }
        REP_END(); }
      MARK(5);
      { PH_TID(); __syncthreads(); p_moe_weights(args, lds, gw, NGW, wave, lane, split ? NI_EARLY : 0, NI_MOE); __syncthreads(); }
      MARK(6);
    }
    SEAM(11);
    if (IN(12)) { REPS(12) { pg8::Gemm g{Y + MIX_OFF, (const bf16*)(ws + WS_WO1), T, D, D, LDY, D, 0}; pg8::StaticOrder S; S.init(T, D, G, bx);
        pg8::EpiBf16 E{(bf16*)(ws + WS_X), D, nullptr, -1, nullptr, 1.0f};
        pg8::gemm_phase<pg8::EpiBf16, pg8::StaticOrder, true, true>(lds + RING_OFF, g, S, E); REP_END(); } }
    SEAM(12);
    if (IN(13)) { PH_TID();
        LAS unsigned* lc = (LAS unsigned*)(lds + RING_OFF);
        const float* wr = args.in[19]; const float* gf = args.in[4] + D;
        LAS float* WRL = (LAS float*)(lds + RING_OFF + 4096);
        for (int i = tid; i < 8 * D; i += NTHR) { const int k = i >> 3, e = i & 7, ln = (k & 255) >> 2, j = k >> 8, c = k & 3; WRL[((((j * 4 + c) * 2 + (e >> 2)) * 64 + ln) * 4) + (e & 3)] = wr[i] * gf[k]; }
        for (int blk = vcu; blk < T / 128; blk += G) {
            if (tid < 16) lc[tid] = 0u;
            __syncthreads();
            f32x4 xn[4]; unsigned long long dn[4];
#define P13_LOAD(m_) do { const GAS f32x4* xr_ = (const GAS f32x4*)(OUT + (size_t)(m_) * D) + lane; const GAS unsigned long long* dr_ = (const GAS unsigned long long*)((const bf16*)(ws + WS_X) + (size_t)(m_) * D) + lane; \
        _Pragma("unroll") for (int j = 0; j < 4; ++j) { xn[j] = __builtin_nontemporal_load(xr_ + 64 * j); dn[j] = __builtin_nontemporal_load(dr_ + 64 * j); } } while (0)
            P13_LOAD(blk * 128 + wave * 16);
#pragma unroll 1
            for (int jj = 0; jj < 16; ++jj) { const int m = blk * 128 + wave * 16 + jj;
                GAS f32x4* xr = (GAS f32x4*)(OUT + (size_t)m * D) + lane;
                float s = 0.f; float lg[8]; f32x4 xv[4]; unsigned long long dv[4];
#pragma unroll
                for (int j = 0; j < 4; ++j) { xv[j] = xn[j]; dv[j] = dn[j]; }
                if (jj < 15) P13_LOAD(m + 1);
#pragma unroll
                for (int e = 0; e < 8; ++e) lg[e] = 0.f;
#pragma unroll
                for (int j = 0; j < 4; ++j) { f32x4 v = xv[j]; const unsigned long long dd = dv[j];
                    v.x += __uint_as_float((unsigned)dd << 16); v.y += __uint_as_float((unsigned)dd & 0xffff0000u); v.z += __uint_as_float((unsigned)(dd >> 32) << 16); v.w += __uint_as_float((unsigned)(dd >> 32) & 0xffff0000u);
                    __builtin_nontemporal_store(v, xr + 64 * j); xv[j] = v; s += (v.x * v.x + v.y * v.y) + (v.z * v.z + v.w * v.w);
#pragma unroll
                    for (int c = 0; c < 4; ++c) { const float xc = v[c]; const LAS f32x4* wp = (const LAS f32x4*)(WRL + (((j * 4 + c) * 2) * 64 + lane) * 4); const f32x4 w0 = wp[0], w1 = wp[64];
                        lg[0] += xc * w0.x; lg[1] += xc * w0.y; lg[2] += xc * w0.z; lg[3] += xc * w0.w; lg[4] += xc * w1.x; lg[5] += xc * w1.y; lg[6] += xc * w1.z; lg[7] += xc * w1.w; } }
                const float rstd = 1.0f / sqrtf(wave_sum(s) * (1.f / D) + EPS);
                { GAS unsigned* o8 = (GAS unsigned*)(ws + WS_X + 100 * MiB + (size_t)m * D) + lane; const float rs8 = rstd * F8_SA;
#pragma unroll
                  for (int j = 0; j < 4; ++j) o8[64 * j] = pg8::pack_fp8x4(xv[j].x * rs8, xv[j].y * rs8, xv[j].z * rs8, xv[j].w * rs8); }
#pragma unroll
                for (int e = 0; e < 8; ++e) lg[e] = wave_sum(lg[e]) * rstd;
                int i1 = 0; float v1 = lg[0];
#pragma unroll
                for (int e = 1; e < 8; ++e) if (lg[e] > v1) { v1 = lg[e]; i1 = e; }
                int i2 = -1; float v2 = -INFINITY;
#pragma unroll
                for (int e = 0; e < 8; ++e) if (e != i1 && lg[e] > v2) { v2 = lg[e]; i2 = e; }
                if (lane == 0) { const float w2g = 1.0f / (1.0f + __expf(v1 - v2)); EID[m] = i1 | (i2 << 8); GWT[2 * m] = 1.0f - w2g; GWT[2 * m + 1] = w2g; RSTD[m] = rstd;
                    __hip_atomic_fetch_add(lc + i1, 1u, __ATOMIC_RELAXED, __HIP_MEMORY_SCOPE_WORKGROUP); __hip_atomic_fetch_add(lc + 8 + i2, 1u, __ATOMIC_RELAXED, __HIP_MEMORY_SCOPE_WORKGROUP); }
            }
#undef P13_LOAD
            __syncthreads();
            if (tid < 16) CNTW[blk * 16 + tid] = (int)lc[tid];
            __syncthreads();
        }
    }
    SEAM(13);
    if (IN(14)) { PH_TID();
        LAS int* L = (LAS int*)(lds + RING_OFF);
        for (int i = tid; i < 4096; i += NTHR) L[64 + i] = CNTW[i];
        __syncthreads();
        { const int q = tid & 15, j = tid >> 4; int pt = 0; for (int w2 = j; w2 < T / 128; w2 += 32) pt += L[64 + w2 * 16 + q]; L[4800 + tid] = pt; }
        __syncthreads();
        if (tid < 16) { int tot = 0;
#pragma unroll
            for (int j = 0; j < 32; ++j) tot += L[4800 + j * 16 + tid];
            L[16 + tid] = tot; }
        __syncthreads();
        if (tid < 16) { const int e = tid & 7; int o = 0; for (int q = 0; q < e; ++q) o += (L[16 + q] + L[24 + q] + 255) & ~255; L[tid] = o + (tid >= 8 ? L[16 + e] : 0); }
        __syncthreads();
        if (bx == 0) {
            for (int i = tid; i < 512; i += NTHR) { int e = 7;
                for (int q = 7; q >= 0; --q) if (i * 256 < L[q] + ((L[16 + q] + L[24 + q] + 255) & ~255)) e = q;
                TILEE[i] = e; }
            if (tid == 0) TILEE[512] = (L[7] + ((L[16 + 7] + L[24 + 7] + 255) & ~255)) >> 8;
            for (int i = tid; i < 512; i += NTHR) { int nfb = 0;
                for (int q = 0; q < 8; ++q) { const int c = L[16 + q] + L[24 + q], t0 = L[q] >> 8, nf = c >> 8; if (i >= t0 && i < t0 + nf) TILEE[600 + nfb + (i - t0)] = i; nfb += nf; } }
            if (tid < 8) { const int c = L[16 + tid] + L[24 + tid], r = c & 255; int nlb = 0; for (int q = 0; q < tid; ++q) nlb += ((L[16 + q] + L[24 + q]) & 255) ? 1 : 0;
                if (r) { TILEE[1200 + 3 * nlb] = (L[tid] >> 8) + (c >> 8); TILEE[1200 + 3 * nlb + 1] = tid; TILEE[1200 + 3 * nlb + 2] = r; }
                if (tid == 7) { int nF = 0; for (int q = 0; q < 8; ++q) nF += (L[16 + q] + L[24 + q]) >> 8; TILEE[513] = nF; TILEE[514] = nlb + (r ? 1 : 0); } }
            for (int i = tid; i < 8 * 256; i += NTHR) { const int pe = i >> 8, j = i & 255, c = L[16 + pe] + L[24 + pe], padn = ((c + 255) & ~255) - c;
                if (j < padn) { TOK[L[pe] + c + j] = -1; GATE[L[pe] + c + j] = 0.f; } }
        }
        unsigned char* XS = ws + WS_X;
        for (int blk = vcu; blk < T / 128; blk += G) {
            { const int q = tid & 15, j = tid >> 4; int pp = 0; for (int w2 = j; w2 < blk; w2 += 32) pp += L[64 + w2 * 16 + q]; L[4800 + tid] = pp; }
            __syncthreads();
            if (tid < 16) { int pre = 0;
#pragma unroll
                for (int j = 0; j < 32; ++j) pre += L[4800 + j * 16 + tid];
                L[32 + tid] = L[tid] + pre; }
            int eid = 0, r0 = 0, r1 = 0;
            if (tid < 128) { eid = EID[blk * 128 + tid]; const int e0 = eid & 255, e1 = eid >> 8; const unsigned long long lt = (1ull << lane) - 1ull;
#pragma unroll
                for (int e = 0; e < 8; ++e) { const unsigned long long m0 = __ballot(e0 == e), m1 = __ballot(e1 == e);
                    if (e0 == e) r0 = __popcll(m0 & lt); if (e1 == e) r1 = __popcll(m1 & lt);
                    if (tid == 0) { L[4736 + e] = __popcll(m0); L[4744 + e] = __popcll(m1); } } }
            __syncthreads();
            if (tid < 128) { const int e0 = eid & 255, e1 = eid >> 8;
                if (tid >= 64) { r0 += L[4736 + e0]; r1 += L[4744 + e1]; }
                const int pos0 = L[32 + e0] + r0, pos1 = L[32 + 8 + e1] + r1, m = blk * 128 + tid;
                L[4480 + tid] = pos0; L[4608 + tid] = pos1; POS[m] = pos0; POS[T + m] = pos1;
                TOK[pos0] = m; TOK[pos1] = m; GATE[pos0] = GWT[2 * m]; GATE[pos1] = GWT[2 * m + 1]; }
            __syncthreads();
            v4u rowv[16];
#pragma unroll
            for (int jj = 0; jj < 16; ++jj) rowv[jj] = __builtin_nontemporal_load((const GAS v4u*)(ws + WS_X + 100 * MiB + (size_t)(blk * 128 + wave * 16 + jj) * D) + lane);
#pragma unroll
            for (int jj = 0; jj < 16; ++jj) { const int i = wave * 16 + jj; const int pos0 = L[4480 + i], pos1 = L[4608 + i];
                *((GAS v4u*)(XS + (size_t)pos0 * D) + lane) = rowv[jj]; *((GAS v4u*)(XS + (size_t)pos1 * D) + lane) = rowv[jj]; }
            __syncthreads();
        }
    }
    SEAM(14);
    if (IN(15)) { LAS int* tl = (LAS int*)(lds + 131072); { PH_TID(); tl[tid] = TILEE[tid]; __syncthreads(); }
      REPS(15) { const int nM = __builtin_amdgcn_readfirstlane(TILEE[512]);
        pg8::Gemm g{(const bf16*)(ws + WS_X), (const bf16*)(ws + WS_WGUM), 2 * MOE_ROWS, 2 * FF, D / 2, D / 2, D / 2, (size_t)2 * FF * D / 2}; pg8::MoeOrder S; S.init(nM, 2 * FF, G, bx, tl);
        pg8::EpiSwiGLU8 E{ws + WS_Y, FF, F8_SH};
        pg8::gemm_phase<pg8::EpiSwiGLU8, pg8::MoeOrder, true, true, true, 11>(lds + RING_OFF, g, S, E); REP_END(); } }
    SEAM(15);
#ifdef PROBE_G2K
    if (IN(16)) { const int nM = __builtin_amdgcn_readfirstlane(TILEE[512]);
        pg8::Gemm g{(const bf16*)(ws + WS_Y), (const bf16*)(ws + WS_WDM), 2 * MOE_ROWS, D, PROBE_G2K, FF / 2, FF / 2, (size_t)D * FF / 2}; pg8::MoeOrder S; S.init(nM, D, G, bx, tl);
        pg8::EpiBf16 E{(bf16*)(ws + WS_X), D, nullptr, -1, nullptr, 1.0f};
        pg8::gemm_phase<pg8::EpiBf16, pg8::MoeOrder, true, true, true, 10>(lds + RING_OFF, g, S, E); xcd_barrier(bar); }
#endif
    if (IN(16)) { LAS int* tl = (LAS int*)(lds + 131072); { PH_TID(); tl[tid] = TILEE[tid]; if (tid < 256) tl[512 + tid] = TILEE[600 + tid]; if (tid < 49) tl[768 + tid] = (tid < 48) ? TILEE[1200 + tid] : TILEE[514]; __syncthreads(); }
      REPS(16) { const int nM = __builtin_amdgcn_readfirstlane(TILEE[513]);
        pg8::Gemm g{(const bf16*)(ws + WS_Y), (const bf16*)(ws + WS_WDM), 2 * MOE_ROWS, D, FF / 2, FF / 2, WDP / 2, (size_t)D * WDP / 2}; pg8::MoeOrder S; S.init(nM, D, G, bx, tl); S.so.wgm = G2WGM; S.ft = tl + 512;
        pg8::EpiGateBf16 E{(bf16*)(ws + WS_X), D, GATE, 1.0f};
        pg8::gemm_phase<pg8::EpiGateBf16, pg8::MoeOrder, true, G2SP2, true, 10>(lds + RING_OFF, g, S, E,
#ifdef PROBE_Q
            blockIdx.x == PROBE_BLK ? stamps + 160 + 32 : nullptr
#else
            nullptr
#endif
            );
        MARK(40);
        { PH_TID(); const int l15 = lane & 15, quad = lane >> 4; const int nL = __builtin_amdgcn_readfirstlane(tl[816]);
          int npc = 0; for (int j = 0; j < nL; ++j) npc += (__builtin_amdgcn_readfirstlane(tl[768 + 3 * j + 2]) + 63) >> 6;
          typedef unsigned long long u64x2 __attribute__((ext_vector_type(2))); constexpr int RB = 4;
          const int kg = wave >> 1, half = wave & 1; LAS unsigned char* red = lds + RING_OFF;
          __syncthreads();
          for (int p = vcu; p < npc * 8; p += G) { const int cg = p & 7; int rgi = p >> 3, j = 0;
              for (; j < nL; ++j) { const int n = (__builtin_amdgcn_readfirstlane(tl[768 + 3 * j + 2]) + 63) >> 6; if (rgi < n) break; rgi -= n; }
              const int pm = __builtin_amdgcn_readfirstlane(tl[768 + 3 * j]), e = __builtin_amdgcn_readfirstlane(tl[768 + 3 * j + 1]);
              const int row = pm * 256 + rgi * 64 + l15, cbase = cg * 128 + half * 64;
              const unsigned char* hp = ws + WS_Y + (size_t)row * FF + kg * 704 + quad * 16;
              const unsigned char* wp = ws + WS_WDM + (size_t)e * D * WDP + (size_t)(cbase + l15) * WDP + kg * 704 + quad * 16;
              f32x4 acc[4][RB];
#pragma unroll
              for (int nb = 0; nb < 4; ++nb)
#pragma unroll
                  for (int rb = 0; rb < RB; ++rb) acc[nb][rb] = (f32x4){0.f, 0.f, 0.f, 0.f};
#define LO_BATCH(S0, NS) { u64x2 wv[4][NS], xv[RB][NS]; \
                _Pragma("unroll") for (int i = 0; i < NS; ++i) { _Pragma("unroll") for (int nb = 0; nb < 4; ++nb) wv[nb][i] = *(const GAS u64x2*)(wp + (size_t)(nb * 16) * WDP + ((S0) + i) * 64); \
                    _Pragma("unroll") for (int rb = 0; rb < RB; ++rb) xv[rb][i] = *(const GAS u64x2*)(hp + (size_t)(rb * 16) * FF + ((S0) + i) * 64); } \
                _Pragma("unroll") for (int i = 0; i < NS; ++i) _Pragma("unroll") for (int nb = 0; nb < 4; ++nb) _Pragma("unroll") for (int rb = 0; rb < RB; ++rb) { \
                    acc[nb][rb] = __builtin_amdgcn_mfma_f32_16x16x32_fp8_fp8((long)wv[nb][i].x, (long)xv[rb][i].x, acc[nb][rb], 0, 0, 0); \
                    acc[nb][rb] = __builtin_amdgcn_mfma_f32_16x16x32_fp8_fp8((long)wv[nb][i].y, (long)xv[rb][i].y, acc[nb][rb], 0, 0, 0); } }
              LO_BATCH(0, 3) LO_BATCH(3, 3) LO_BATCH(6, 3) LO_BATCH(9, 2)
#undef LO_BATCH
              if (kg > 0) {
#pragma unroll
                  for (int nb = 0; nb < 4; ++nb)
#pragma unroll
                      for (int rb = 0; rb < RB; ++rb) *(LAS f32x4*)(red + ((kg - 1) * 2 + half) * (4 * RB * 1024) + (nb * RB + rb) * 1024 + lane * 16) = acc[nb][rb]; }
              __syncthreads();
              if (kg == 0) { float gt[RB];
#pragma unroll
                  for (int rb = 0; rb < RB; ++rb) gt[rb] = GATE[row + 16 * rb] * (1.0f / 1024.0f);
                  bf16* y0 = (bf16*)(ws + WS_X) + (size_t)row * D + cbase + 4 * quad; typedef unsigned u32x2 __attribute__((ext_vector_type(2)));
#pragma unroll
                  for (int nb = 0; nb < 4; ++nb)
#pragma unroll
                      for (int rb = 0; rb < RB; ++rb) { f32x4 v = acc[nb][rb];
#pragma unroll
                          for (int q = 0; q < 3; ++q) v += *(const LAS f32x4*)(red + (q * 2 + half) * (4 * RB * 1024) + (nb * RB + rb) * 1024 + lane * 16);
                          const float g = gt[rb]; u32x2 o; o.x = pk2(v[0] * g, v[1] * g); o.y = pk2(v[2] * g, v[3] * g);
                          *(GAS u32x2*)(y0 + (size_t)(rb * 16) * D + nb * 16) = o; } }
              __syncthreads(); } }
        MARK(41);
        REP_END(); } }
    if (IN(16) && IN(19)) STAMP_BAR(17);
    if (IN(19)) { PH_TID(); const float* gfin = args.in[6]; const bf16* Y20 = (const bf16*)(ws + WS_X); const bf16* Y21 = Y20;
        unsigned long long an[4], cn[4]; f32x4 xn[4];
#define P19_LOAD(mm_, q0_, q1_) do { const GAS unsigned long long* y0_ = (const GAS unsigned long long*)(Y20 + (size_t)(q0_) * D) + lane; const GAS unsigned long long* y1_ = (const GAS unsigned long long*)(Y21 + (size_t)(q1_) * D) + lane; \
            const GAS f32x4* xr_ = (const GAS f32x4*)(OUT + (size_t)(mm_) * D) + lane; \
            _Pragma("unroll") for (int j = 0; j < 4; ++j) { an[j] = __builtin_nontemporal_load(y0_ + 64 * j); cn[j] = __builtin_nontemporal_load(y1_ + 64 * j); xn[j] = __builtin_nontemporal_load(xr_ + 64 * j); } } while (0)
        if (gw < T) {
            f32x4 gg4[4];
#pragma unroll
            for (int j = 0; j < 4; ++j) gg4[j] = *(const f32x4*)(gfin + 4 * lane + 256 * j);
            { const int q0 = POS[gw], q1 = POS[T + gw]; P19_LOAD(gw, q0, q1); }
            int mn = gw + NGW < T ? gw + NGW : gw; int r0 = POS[mn], r1 = POS[T + mn];
#pragma unroll 1
            for (int m = gw; m < T; m += NGW) { GAS f32x4* xr = (GAS f32x4*)(OUT + (size_t)m * D) + lane; f32x4 v[4]; float s = 0.f;
                unsigned long long a4[4], c4[4]; f32x4 x4[4];
#pragma unroll
                for (int j = 0; j < 4; ++j) { a4[j] = an[j]; c4[j] = cn[j]; x4[j] = xn[j]; }
                const int ml = m + NGW < T ? m + NGW : m;
                P19_LOAD(ml, r0, r1);
                { const int m2 = m + 2 * NGW < T ? m + 2 * NGW : ml; r0 = POS[m2]; r1 = POS[T + m2]; }
#pragma unroll
                for (int j = 0; j < 4; ++j) { const unsigned long long a = a4[j], c = c4[j]; f32x4 x = x4[j];
                    x.x += __uint_as_float((unsigned)a << 16) + __uint_as_float((unsigned)c << 16); x.y += __uint_as_float((unsigned)a & 0xffff0000u) + __uint_as_float((unsigned)c & 0xffff0000u);
                    x.z += __uint_as_float((unsigned)(a >> 32) << 16) + __uint_as_float((unsigned)(c >> 32) << 16); x.w += __uint_as_float((unsigned)(a >> 32) & 0xffff0000u) + __uint_as_float((unsigned)(c >> 32) & 0xffff0000u);
                    v[j] = x; s += (x.x * x.x + x.y * x.y) + (x.z * x.z + x.w * x.w); }
                const float rstd = 1.0f / sqrtf(wave_sum(s) * (1.f / D) + EPS);
#pragma unroll
                for (int j = 0; j < 4; ++j) __builtin_nontemporal_store(v[j] * rstd * gg4[j], xr + 64 * j); } }
#undef P19_LOAD
    }
#ifdef PROBE_Q
    if (threadIdx.x == 0 && blockIdx.x == 0) { const unsigned long long tend = __builtin_amdgcn_s_memrealtime(); unsigned long long Q = 0;
        for (int j = 0; j < 18; ++j) { const unsigned long long F = ~__hip_atomic_load(stamps + j, RLX_AGENT), L = __hip_atomic_load(stamps + 32 + j, RLX_AGENT), R = stamps[64 + j], Rp = j ? stamps[64 + j - 1] : stamps[96];
            if (PROBE_Q == 1) Q += R - L;
            else if (PROBE_Q == 2) Q += L - F;
            else if (PROBE_Q == 3 && j == PROBE_P) Q += L - Rp;
            else if (PROBE_Q == 4 && j == PROBE_P) Q += L - F;
            else if (PROBE_Q == 5 && j == PROBE_P) Q += R - L;
            else if (PROBE_Q == 7 && j == 0) Q += stamps[160 + PROBE_P + 1] - stamps[160 + PROBE_P];
            else if (PROBE_Q == 8 && j == 0) Q += stamps[160 + PROBE_P2] - stamps[160 + PROBE_P];
            else if (PROBE_Q == 6 && j == PROBE_P) Q += __hip_atomic_load(stamps + 128 + j, RLX_AGENT) - Rp; }
        if (PROBE_Q == 3 && PROBE_P == 18) Q = tend - stamps[64 + 17];
        while (__builtin_amdgcn_s_memrealtime() - tend < (unsigned long long)PROBE_AMP * Q) __builtin_amdgcn_s_sleep(8); }
#endif
#undef IN
#undef SEAM
#undef PH_TID
#undef REPS
#undef DRYSC
#undef REP_END
}

#ifndef MK_PER_PHASE
#define MK_PER_PHASE 0
#endif
extern "C" void kernel_launch(void* const* d_in, const int* in_sizes, int n_in, void* d_out, int out_size, void* d_ws, size_t ws_size, hipStream_t stream) {
    static int grid = 0;
    if (grid == 0) {
        if (n_in != 23 || in_sizes[0] != T * D || out_size != T * D || ws_size < WS_END) { fprintf(stderr, "kernel_launch: unexpected shapes (n_in %d, in0 %d, out %d, ws %zu)\n", n_in, n_in > 0 ? in_sizes[0] : -1, out_size, ws_size); grid = -1; return; }
        int dev = 0, cus = 0, per_cu = 0;
        if (hipGetDevice(&dev) != hipSuccess || hipDeviceGetAttribute(&cus, hipDeviceAttributeMultiprocessorCount, dev) != hipSuccess) { grid = -1; return; }
        if (hipFuncSetAttribute((const void*)fwd_kernel, hipFuncAttributeMaxDynamicSharedMemorySize, LDS_BYTES) != hipSuccess) { fprintf(stderr, "kernel_launch: hipFuncSetAttribute failed\n"); grid = -1; return; }
        if (hipOccupancyMaxActiveBlocksPerMultiprocessor(&per_cu, (const void*)fwd_kernel, NTHR, LDS_BYTES) != hipSuccess || per_cu < 1) fprintf(stderr, "kernel_launch: occupancy query says %d\n", per_cu);
        (void)hipGetLastError();
        grid = cus;
    }
    if (grid < 0) return;
    if (hipMemsetAsync((char*)d_ws + WS_CTL, 0, CTL_ZERO_BYTES, stream) != hipSuccess) return;
    Args a{};
    for (int i = 0; i < 23; ++i) a.in[i] = (const float*)d_in[i];
    a.out = (float*)d_out; a.ws = (unsigned char*)d_ws;
#if MK_PER_PHASE
    for (int p = 0; p <= N_PHASES; ++p) { a.ph_lo = p; a.ph_hi = p + 1; hipLaunchKernelGGL(fwd_kernel, dim3(grid), dim3(NTHR), LDS_BYTES, stream, a); }
#else
    a.ph_lo = 0; a.ph_hi = N_PHASES + 1;
    hipLaunchKernelGGL(fwd_kernel, dim3(grid), dim3(NTHR), LDS_BYTES, stream, a);
#endif
}
```
